# Optimizing an MI355X kernel written in HIP

```python
import jax, jax.numpy as jnp
from jax import lax
import numpy as np

D_MODEL = 1024
BATCH = 8
SEQ = 4096
DEPTH = 2
DEC_BATCH = 2
DEC_SEQ = 16384
PAST_LEN = 128

ROPE_THETA = 10000.0
EPS = 1e-6
NEG_INF = -1e30
MLA_HEADS = 8
MLA_NOPE = 64
MLA_ROPE = 32
MLA_V = 64
Q_LORA = 384
KV_LORA = 256
MLA_WIDTH = MLA_HEADS * MLA_V
MLA_QBLOCK = 128
DIL_GROUPS = ((128, 1), (512, 4), (2048, 16))
DIL_HEADS = 8
DIL_HEAD_DIM = 64
DIL_WIDTH = DIL_HEADS * DIL_HEAD_DIM
N_BRANCH = 2
IN_SPLITS = (Q_LORA, KV_LORA, MLA_ROPE, MLA_WIDTH) + (DIL_WIDTH,) * (3 * len(DIL_GROUPS)) + (DIL_WIDTH, N_BRANCH * D_MODEL)
IN_WIDTH = sum(IN_SPLITS)

kernel_name = "hybrid_mla_dilated_encoder"


def _split_in(u):
    offs, acc = [], 0
    for w in IN_SPLITS[:-1]:
        acc += w
        offs.append(acc)
    return jnp.split(u, offs, axis=-1)


def _rmsnorm(x, g):
    xf = x.astype(jnp.float32)
    y = xf * lax.rsqrt(jnp.mean(xf * xf, axis=-1, keepdims=True) + EPS)
    return (y * g.astype(jnp.float32)).astype(x.dtype)


def _rope(x, pos):
    d = x.shape[-1]
    inv = jnp.power(jnp.float32(ROPE_THETA), -jnp.arange(0, d, 2, dtype=jnp.float32) / d)
    ang = pos[:, None] * inv[None, :]
    cos = jnp.cos(ang)[None, :, None, :]
    sin = jnp.sin(ang)[None, :, None, :]
    xf = x.astype(jnp.float32)
    x1, x2 = xf[..., : d // 2], xf[..., d // 2:]
    return jnp.concatenate([x1 * cos - x2 * sin, x1 * sin + x2 * cos], axis=-1).astype(x.dtype)


def _mla_attention(q, k, v):
    B, S, H, dq = q.shape
    scale = dq ** -0.5
    nq = S // MLA_QBLOCK
    qb = q.reshape(B, nq, MLA_QBLOCK, H, dq).transpose(1, 0, 2, 3, 4)

    def one(qblk):
        s = jnp.einsum('bqhe,bkhe->bhqk', qblk, k, preferred_element_type=jnp.float32) * scale
        p = jax.nn.softmax(s, axis=-1)
        return jnp.einsum('bhqk,bkhe->bqhe', p, v.astype(jnp.float32)).astype(q.dtype)

    o = lax.map(one, qb)
    return o.transpose(1, 0, 2, 3, 4).reshape(B, S, H, v.shape[-1])


def _dilated_group_attention(q, k, v, window, dil):
    B, S, H, dh = q.shape
    half = window // (2 * dil)
    blk = half
    span = dil * blk
    S_pad = -(-S // span) * span
    pad = S_pad - S
    L = S_pad // dil
    nb = L // blk

    def strided(t):
        t = jnp.pad(t, ((0, 0), (0, pad), (0, 0), (0, 0)))
        t = t.reshape(B, L, dil, H, dh).transpose(0, 2, 1, 3, 4)
        return t.reshape(B, dil, nb, blk, H, dh)

    def neighbours(t):
        tp = jnp.pad(t, ((0, 0), (0, 0), (1, 1), (0, 0), (0, 0), (0, 0)))
        return jnp.concatenate([tp[:, :, :-2], tp[:, :, 1:-1], tp[:, :, 2:]], axis=3)

    qs = strided(q)
    kw = neighbours(strided(k))
    vw = neighbours(strided(v))

    valid = (jnp.arange(S_pad) < S).reshape(L, dil).T.reshape(dil, nb, blk)
    vp = jnp.pad(valid, ((0, 0), (1, 1), (0, 0)))
    kvalid = jnp.concatenate([vp[:, :-2], vp[:, 1:-1], vp[:, 2:]], axis=2)
    rel = (jnp.arange(3 * blk)[None, :] - blk) - jnp.arange(blk)[:, None]
    mask = (jnp.abs(rel) <= half)[None, None] & kvalid[:, :, None, :]

    s = jnp.einsum('bdnqhe,bdnkhe->bdnhqk', qs, kw, preferred_element_type=jnp.float32) * (dh ** -0.5)
    s = jnp.where(mask[None, :, :, None], s, NEG_INF)
    m = jnp.max(s, axis=-1, keepdims=True)
    p = jnp.exp(s - m)
    l = jnp.sum(p, axis=-1, keepdims=True)
    o = jnp.einsum('bdnhqk,bdnkhe->bdnqhe', p / l, vw.astype(jnp.float32))
    lse = (m + jnp.log(l))[..., 0]

    o = o.reshape(B, dil, L, H, dh).transpose(0, 2, 1, 3, 4).reshape(B, S_pad, H, dh)[:, :S]
    lse = lse.transpose(0, 1, 2, 4, 3).reshape(B, dil, L, H).transpose(0, 2, 1, 3).reshape(B, S_pad, H)[:, :S]
    return o, lse


def _layer(x, c, pos, w_ada, b_ada, g_norm, w_in, b_gate, g_cq, w_uq, g_ckv, w_ukv, w_pa, w_pb, w_out):
    B, S, _ = x.shape
    mod = jax.nn.silu(c) @ w_ada + b_ada
    shift, scale, gate = jnp.split(mod, 3, axis=-1)
    h = _rmsnorm(x, g_norm) * (1.0 + scale[:, None, :]) + shift[:, None, :]

    parts = _split_in(h @ w_in)
    cq, ckv, kr, z_mla = parts[0], parts[1], parts[2], parts[3]
    z_dil, merge = parts[4 + 3 * len(DIL_GROUPS)], parts[5 + 3 * len(DIL_GROUPS)]

    q = (_rmsnorm(cq, g_cq) @ w_uq).reshape(B, S, MLA_HEADS, MLA_NOPE + MLA_ROPE)
    q = jnp.concatenate([q[..., :MLA_NOPE], _rope(q[..., MLA_NOPE:], pos)], axis=-1)
    kv = (_rmsnorm(ckv, g_ckv) @ w_ukv).reshape(B, S, MLA_HEADS, MLA_NOPE + MLA_V)
    k_pe = jnp.broadcast_to(_rope(kr.reshape(B, S, 1, MLA_ROPE), pos), (B, S, MLA_HEADS, MLA_ROPE))
    k = jnp.concatenate([kv[..., :MLA_NOPE], k_pe], axis=-1)
    v = kv[..., MLA_NOPE:]
    o_mla = _mla_attention(q, k, v).reshape(B, S, MLA_WIDTH) * jax.nn.silu(z_mla)

    outs, lses = [], []
    for gi, (win, dil) in enumerate(DIL_GROUPS):
        qg, kg, vg = [t.reshape(B, S, DIL_HEADS, DIL_HEAD_DIM) for t in parts[4 + 3 * gi: 7 + 3 * gi]]
        og, lg = _dilated_group_attention(_rope(qg, pos), _rope(kg, pos), vg, win, dil)
        outs.append(og)
        lses.append(lg)
    wts = jax.nn.softmax(jnp.stack(lses, axis=0), axis=0)
    o_dil = jnp.sum(wts[..., None] * jnp.stack(outs, axis=0), axis=0).astype(x.dtype)
    o_dil = o_dil.reshape(B, S, DIL_WIDTH) * jax.nn.silu(z_dil)

    ga, gb = jnp.split(jax.nn.sigmoid(merge + b_gate), 2, axis=-1)
    y = (ga * (o_mla @ w_pa) + gb * (o_dil @ w_pb)) @ w_out
    return x + gate[:, None, :] * y


def _trunk(x, c, w_ada, b_ada, g_norm, w_in, b_gate, g_cq, w_uq, g_ckv, w_ukv, w_pa, w_pb, w_out, g_final):
    pos = jnp.arange(x.shape[1], dtype=jnp.float32)
    for l in range(DEPTH):
        x = _layer(x, c, pos, w_ada[l], b_ada[l], g_norm[l], w_in[l], b_gate[l], g_cq[l], w_uq[l],
                   g_ckv[l], w_ukv[l], w_pa[l], w_pb[l], w_out[l])
    return _rmsnorm(x, g_final)


def setup_inputs(seed: int = 0) -> dict:
    key = jax.random.key(seed)
    ks = jax.random.split(key, 20)
    f32 = jnp.float32
    nrm = lambda k, shape, s: jax.random.normal(k, shape, f32) * s
    D = D_MODEL
    return {
        "x_prompt": nrm(ks[0], (BATCH, SEQ, D), 1.0),
        "x_sample": nrm(ks[1], (DEC_BATCH, DEC_SEQ, D), 1.0),
        "c_prompt": nrm(ks[2], (BATCH, D), 1.0),
        "c_sample": nrm(ks[3], (DEC_BATCH, D), 1.0),
        "w_ada": nrm(ks[4], (DEPTH, D, 3 * D), D ** -0.5),
        "b_ada": nrm(ks[5], (DEPTH, 3 * D), 0.02),
        "g_norm": 1.0 + nrm(ks[6], (DEPTH, D), 0.02),
        "w_in": nrm(ks[7], (DEPTH, D, IN_WIDTH), D ** -0.5),
        "b_gate": nrm(ks[8], (DEPTH, N_BRANCH * D), 0.02),
        "g_cq": 1.0 + nrm(ks[9], (DEPTH, Q_LORA), 0.02),
        "w_uq": nrm(ks[10], (DEPTH, Q_LORA, MLA_HEADS * (MLA_NOPE + MLA_ROPE)), Q_LORA ** -0.5),
        "g_ckv": 1.0 + nrm(ks[11], (DEPTH, KV_LORA), 0.02),
        "w_ukv": nrm(ks[12], (DEPTH, KV_LORA, MLA_HEADS * (MLA_NOPE + MLA_V)), KV_LORA ** -0.5),
        "w_pa": nrm(ks[13], (DEPTH, MLA_WIDTH, D), MLA_WIDTH ** -0.5),
        "w_pb": nrm(ks[14], (DEPTH, DIL_WIDTH, D), DIL_WIDTH ** -0.5),
        "w_out": nrm(ks[15], (DEPTH, D, D), D ** -0.5),
        "g_final": 1.0 + nrm(ks[16], (D,), 0.02),
    }


def reference(x_prompt, x_sample, c_prompt, c_sample, w_ada, b_ada, g_norm, w_in, b_gate, g_cq, w_uq,
              g_ckv, w_ukv, w_pa, w_pb, w_out, g_final):
    y_prompt = _trunk(x_prompt, c_prompt, w_ada, b_ada, g_norm, w_in, b_gate, g_cq, w_uq, g_ckv, w_ukv,
                      w_pa, w_pb, w_out, g_final)
    y_sample = _trunk(x_sample, c_sample, w_ada, b_ada, g_norm, w_in, b_gate, g_cq, w_uq, g_ckv, w_ukv,
                      w_pa, w_pb, w_out, g_final)
    return (y_prompt, y_sample)
```

```cpp
#include <hip/hip_runtime.h>
#include <hip/hip_cooperative_groups.h>
#include <cstdio>
namespace cg = cooperative_groups;

typedef unsigned short bf16_t;
typedef __attribute__((ext_vector_type(8))) short bf16x8;
typedef __attribute__((ext_vector_type(4))) short s16x4;
typedef __attribute__((ext_vector_type(2))) float f32x2;
typedef __attribute__((ext_vector_type(16))) float f32x16;
typedef __attribute__((ext_vector_type(2))) __bf16 bf2_t;
typedef __attribute__((ext_vector_type(4))) unsigned u32x4;
typedef __attribute__((ext_vector_type(2))) unsigned u32x2;
typedef __attribute__((ext_vector_type(4))) float f32x4v;
typedef __attribute__((address_space(3))) s16x4 lds_s16x4;

#define DI __device__ __forceinline__
#define MFMA(a, b, c) __builtin_amdgcn_mfma_f32_32x32x16_bf16((a), (b), (c), 0, 0, 0)

constexpr int TR = 16384;
constexpr int NPAD = 8448;
constexpr float EPSN = 1e-6f;
constexpr float LOG2E = 1.4426950408889634f;

constexpr size_t OFF_WIN = 0;
constexpr size_t OFF_WUQ = OFF_WIN + (size_t)2 * NPAD * 1024 * 2;
constexpr size_t OFF_WUKV = OFF_WUQ + (size_t)2 * 768 * 384 * 2;
constexpr size_t OFF_WPA = OFF_WUKV + (size_t)2 * 1024 * 256 * 2;
constexpr size_t OFF_WPB = OFF_WPA + (size_t)2 * 1024 * 512 * 2;
constexpr size_t OFF_WOUT = OFF_WPB + (size_t)2 * 1024 * 512 * 2;
constexpr size_t OFF_ROPE64 = OFF_WOUT + (size_t)2 * 1024 * 1024 * 2;
constexpr size_t OFF_ROPE32 = OFF_ROPE64 + (size_t)16384 * 32 * 8;
constexpr size_t OFF_MOD = OFF_ROPE32 + (size_t)16384 * 16 * 8;
constexpr size_t OFF_ACT = OFF_MOD + (size_t)2 * 10 * 3072 * 4;
constexpr size_t OFF_H = OFF_ACT;
constexpr size_t OFF_CQ = OFF_H + (size_t)TR * 1024 * 2;
constexpr size_t OFF_CKV = OFF_CQ + (size_t)TR * 384 * 2;
constexpr size_t OFF_OG = OFF_H;
constexpr size_t OFF_KPE = OFF_CKV + (size_t)TR * 256 * 2;
constexpr size_t OFF_ZM = OFF_KPE + (size_t)TR * 32 * 2;
constexpr size_t OFF_DIL = OFF_ZM + (size_t)TR * 512 * 2;
constexpr size_t OFF_TB = OFF_DIL;
constexpr size_t OFF_OD = OFF_DIL + (size_t)TR * 1024 * 2;
constexpr size_t OFF_T1 = OFF_DIL + (size_t)TR * 1536 * 2;
constexpr size_t OFF_ZD = OFF_DIL + (size_t)TR * 4608 * 2;
constexpr size_t OFF_MG = OFF_ZD + (size_t)TR * 512 * 2;
constexpr size_t OFF_QM = OFF_MG + (size_t)TR * 2048 * 2;
constexpr size_t OFF_KN = OFF_QM + (size_t)TR * 768 * 2;
constexpr size_t OFF_VM = OFF_KN + (size_t)TR * 512 * 2;
constexpr size_t OFF_OM = OFF_VM + (size_t)TR * 512 * 2;
constexpr size_t OFF_LSE = OFF_OM + (size_t)TR * 512 * 2;
constexpr size_t OFF_BAR = OFF_LSE + (size_t)3 * TR * 8 * 4;
constexpr size_t WS_END = OFF_BAR + 16384;

constexpr int NTHR = 512;
constexpr int LDS_BYTES = 147456 + 1024;

struct Params {
  const float *x_prompt, *x_sample, *c_prompt, *c_sample, *w_ada, *b_ada, *g_norm, *w_in, *b_gate, *g_cq, *w_uq,
      *g_ckv, *w_ukv, *w_pa, *w_pb, *w_out, *g_final;
  float* out;
  char* ws;
};

DI unsigned pk2(float a, float b) {
  f32x2 v = {a, b};
  bf2_t r = __builtin_convertvector(v, bf2_t);
  return __builtin_bit_cast(unsigned, r);
}
DI float bflo(unsigned u) { return __uint_as_float(u << 16); }
DI float bfhi(unsigned u) { return __uint_as_float(u & 0xffff0000u); }
DI int crow(int i, int h) { return (i & 3) + 8 * (i >> 2) + 4 * h; }
DI float silu_f(float x) { return x / (1.f + __expf(-x)); }
DI float sigm_f(float x) { return 1.f / (1.f + __expf(-x)); }
DI float ex2(float x) { return __builtin_amdgcn_exp2f(x); }

template <int S_>
DI bf16x8 pack_step(const f32x16& x) {
  u32x4 p = {pk2(x[8 * S_], x[8 * S_ + 1]), pk2(x[8 * S_ + 2], x[8 * S_ + 3]), pk2(x[8 * S_ + 4], x[8 * S_ + 5]),
             pk2(x[8 * S_ + 6], x[8 * S_ + 7])};
  return __builtin_bit_cast(bf16x8, p);
}
DI void zero16(f32x16& a) {
#pragma unroll
  for (int i = 0; i < 16; ++i) a[i] = 0.f;
}
DI void store4(bf16_t* dst, float a, float b, float c, float d) {
  u32x2 v = {pk2(a, b), pk2(c, d)};
  *(u32x2*)dst = v;
}
DI bf16x8 tr_frag(const char* p0, const char* p1) {
  s16x4 lo = __builtin_amdgcn_ds_read_tr16_b64_v4i16((lds_s16x4*)p0);
  s16x4 hi = __builtin_amdgcn_ds_read_tr16_b64_v4i16((lds_s16x4*)p1);
  return __builtin_shufflevector(lo, hi, 0, 1, 2, 3, 4, 5, 6, 7);
}

DI int lane_id() { return (int)__builtin_amdgcn_mbcnt_hi(~0u, __builtin_amdgcn_mbcnt_lo(~0u, 0u)); }
DI int tid_opaque(int wv) {
  int t = (wv << 6) | lane_id();
  asm volatile("" : "+v"(t));
  return t;
}
DI char* ptr_opaque(char* p) {
  size_t off = 0;
  asm volatile("" : "+s"(off));
  return p + off;
}

#define XB_TMO 128
#define XB_XCNT(j) (256 + 64 * (j))
#define XB_XSUB(j) (1280 + 64 * (j))
#define XB_XGEN(j) (2304 + 64 * (j))
#define XB_TOP 3328
#define XB_TOPGEN 3392
#define XCD_BAR_WORDS 3456
#define XB_SPIN_CAP (1u << 20)
#define LAS __attribute__((address_space(3)))
DI unsigned xb_ld(unsigned* p) { return __hip_atomic_load(p, __ATOMIC_RELAXED, __HIP_MEMORY_SCOPE_AGENT); }
DI unsigned xb_add(unsigned* p, unsigned v) { return __hip_atomic_fetch_add(p, v, __ATOMIC_RELAXED, __HIP_MEMORY_SCOPE_AGENT); }
DI unsigned xb_xcc_id() { return (unsigned)__builtin_amdgcn_s_getreg((3 << 11) | 20) & 0xFu; }
#define XB_SPIN(cond, bar)                                   \
  do {                                                       \
    unsigned _sp = 0;                                        \
    while (cond) {                                           \
      __builtin_amdgcn_s_sleep(1);                           \
      if ((++_sp & 255u) == 0u) {                            \
        if (xb_ld(&(bar)[XB_TMO])) break;                    \
        if (_sp > XB_SPIN_CAP) {                             \
          atomicAdd(&(bar)[XB_TMO], 1u);                     \
          break;                                             \
        }                                                    \
      }                                                      \
    }                                                        \
  } while (0)
struct XcdBarrier {
  unsigned* bar;
  unsigned x;
  volatile LAS unsigned* st;
};
DI XcdBarrier xcd_barrier_post(unsigned* bar, volatile LAS unsigned* st) {
  XcdBarrier b;
  b.bar = bar;
  b.x = xb_xcc_id();
  b.st = st;
  if (threadIdx.x == 0) (void)xb_add(&bar[XB_XCNT(b.x)], 1u);
  return b;
}
DI void xcd_barrier_complete(unsigned* bar, unsigned x, unsigned& nloc, unsigned& nx) {
  const unsigned G = gridDim.x * gridDim.y * gridDim.z;
  unsigned sum, cnt, mine, sp = 0u;
  for (;;) {
    sum = 0u; cnt = 0u; mine = 0u;
#pragma unroll
    for (unsigned j = 0; j < 16; ++j) {
      const unsigned c = xb_ld(&bar[XB_XCNT(j)]);
      sum += c;
      cnt += (c > 0u) ? 1u : 0u;
      mine = (j == x) ? c : mine;
    }
    if (sum == G) break;
    __builtin_amdgcn_s_sleep(1);
    if ((++sp & 255u) == 0u) {
      if (xb_ld(&bar[XB_TMO])) break;
      if (sp > XB_SPIN_CAP) { atomicAdd(&bar[XB_TMO], 1u); break; }
    }
  }
  nloc = mine > 0u ? mine : 1u;
  nx = cnt > 0u ? cnt : 1u;
}
DI void xcd_barrier(const XcdBarrier& b, int wv, char* wsbase) {
  asm volatile("s_waitcnt vmcnt(0)" ::: "memory");
  __syncthreads();
  if (wv == 0 && lane_id() == 0) {
    unsigned* bar = (unsigned*)(ptr_opaque(wsbase) + OFF_BAR);
    const unsigned bx = xb_xcc_id();
    __builtin_amdgcn_s_waitcnt(0);
    unsigned nloc = b.st[0], nx = b.st[1];
    if (nloc == 0u) {
      xcd_barrier_complete(bar, bx, nloc, nx);
      b.st[0] = nloc;
      b.st[1] = nx;
    }
    const unsigned old = xb_add(&bar[XB_XSUB(bx)], 1u);
    const unsigned gen = old / nloc;
    if (old + 1u == (gen + 1u) * nloc) {
      __builtin_amdgcn_fence(__ATOMIC_RELEASE, "agent");
      asm volatile("s_waitcnt vmcnt(0)" ::: "memory");
      const unsigned og = xb_add(&bar[XB_TOP], 1u);
      const unsigned tg = og / nx;
      if (og + 1u == (tg + 1u) * nx) xb_add(&bar[XB_TOPGEN], 1u);
      else XB_SPIN(xb_ld(&bar[XB_TOPGEN]) == tg, bar);
      __builtin_amdgcn_fence(__ATOMIC_ACQUIRE, "agent");
      xb_add(&bar[XB_XGEN(bx)], 1u);
      asm volatile("s_waitcnt vmcnt(0)" ::: "memory");
    } else {
      XB_SPIN(xb_ld(&bar[XB_XGEN(bx)]) == gen, bar);
      __builtin_amdgcn_fence(__ATOMIC_ACQUIRE, "agent");
      asm volatile("s_waitcnt vmcnt(0)" ::: "memory");
    }
  }
  __syncthreads();
}

DI void vxcd(int& x, int& q, int& nq, int& mper) {
  const bool eight = (gridDim.x & 7) == 0;
  x = eight ? (int)(blockIdx.x & 7) : 0;
  q = eight ? (int)(blockIdx.x >> 3) : (int)blockIdx.x;
  nq = eight ? (int)(gridDim.x >> 3) : (int)gridDim.x;
  mper = eight ? 8 : 64;
}
DI bool xcd_tile256(int j, int NT, int& mt, int& nt) {
  int x, q, nq, mper;
  vxcd(x, q, nq, mper);
  const int e = q + j * nq;
  if (e >= mper * NT) return false;
  nt = e / mper;
  mt = x * mper + e % mper;
  return true;
}

DI bool xcd_tile256_p1(int j, int& mt, int& nt) {
  int x, q, nq, mper;
  vxcd(x, q, nq, mper);
  const int half = mper >> 1;
  const int e = q + j * nq;
  if (e >= mper * 32) return false;
  const int pass = e / (half * 32), rem = e % (half * 32);
  nt = rem / half;
  mt = x * mper + pass * half + rem % half;
  return true;
}

DI void gemm_core256(const bf16_t* Wt, const bf16_t* X, int K, f32x16 (&acc)[2][4], char* lds, int wv) {
  const int t = tid_opaque(wv), lane = t & 63, w = t >> 6, r = lane & 31, h = lane >> 5, wn = w & 3, wm = w >> 2;
  const int lrow = t >> 3, lpart = t & 7;
  const bf16_t* gw = Wt + (size_t)lrow * K + lpart * 8;
  const bf16_t* gx = X + (size_t)lrow * K + lpart * 8;
  char* stw = lds + lrow * 144 + lpart * 16;
  const char* wsp0 = lds + (wn * 64 + r) * 144 + h * 16;
  const char* xsp0 = lds + 36864 + (wm * 128 + r) * 144 + h * 16;
  u32x4 rw[4], rx[4];
  const int nk = K >> 6;
  __syncthreads();
#pragma unroll
  for (int i = 0; i < 4; ++i) {
    rw[i] = *(const u32x4*)(gw + (size_t)(64 * i) * K);
    rx[i] = *(const u32x4*)(gx + (size_t)(64 * i) * K);
  }
#pragma unroll
  for (int i = 0; i < 4; ++i) {
    *(u32x4*)(stw + i * 64 * 144) = rw[i];
    *(u32x4*)(stw + 36864 + i * 64 * 144) = rx[i];
  }
  __syncthreads();
  for (int kt = 0; kt < nk; ++kt) {
    const bool more = kt + 1 < nk;
    if (more) {
#pragma unroll
      for (int i = 0; i < 4; ++i) {
        rw[i] = *(const u32x4*)(gw + (size_t)(64 * i) * K + (kt + 1) * 64);
        rx[i] = *(const u32x4*)(gx + (size_t)(64 * i) * K + (kt + 1) * 64);
      }
    }
    __builtin_amdgcn_sched_barrier(0);
    {
      const char* wsp = wsp0 + (kt & 1) * 73728;
      const char* xsp = xsp0 + (kt & 1) * 73728;
      char* dnx = stw + ((kt + 1) & 1) * 73728;
      bf16x8 fa[2][2], fb[2][2];
#define LFA(BUF, S)                                         \
  fa[BUF][0] = *(const bf16x8*)(wsp + (S) * 32);            \
  fa[BUF][1] = *(const bf16x8*)(wsp + 32 * 144 + (S) * 32);
#define LFB(BUF, S, HB)                                                         \
  fb[BUF][0] = *(const bf16x8*)(xsp + ((HB) * 2) * 32 * 144 + (S) * 32);        \
  fb[BUF][1] = *(const bf16x8*)(xsp + ((HB) * 2 + 1) * 32 * 144 + (S) * 32);
#define MHALF(AB, BB, HB)                                                       \
  acc[0][(HB) * 2] = MFMA(fa[AB][0], fb[BB][0], acc[0][(HB) * 2]);              \
  acc[1][(HB) * 2] = MFMA(fa[AB][1], fb[BB][0], acc[1][(HB) * 2]);              \
  acc[0][(HB) * 2 + 1] = MFMA(fa[AB][0], fb[BB][1], acc[0][(HB) * 2 + 1]);      \
  acc[1][(HB) * 2 + 1] = MFMA(fa[AB][1], fb[BB][1], acc[1][(HB) * 2 + 1]);
#define WST(I)                                                  \
  if (more) {                                                   \
    *(u32x4*)(dnx + (I) * 64 * 144) = rw[I];                    \
    *(u32x4*)(dnx + 36864 + (I) * 64 * 144) = rx[I];            \
  }
#define SB __builtin_amdgcn_sched_barrier(0);
      LFA(0, 0) LFB(0, 0, 0) SB
      LFB(1, 0, 1) SB
      MHALF(0, 0, 0) SB
      LFA(1, 1) LFB(0, 1, 0) SB
      MHALF(0, 1, 1) SB
      LFB(1, 1, 1) SB
      MHALF(1, 0, 0) SB
      LFA(0, 2) LFB(0, 2, 0) SB
      MHALF(1, 1, 1) SB
      LFB(1, 2, 1) SB
      MHALF(0, 0, 0) SB
      LFA(1, 3) LFB(0, 3, 0) WST(0) SB
      MHALF(0, 1, 1) SB
      LFB(1, 3, 1) WST(1) SB
      MHALF(1, 0, 0) SB
      WST(2) SB
      MHALF(1, 1, 1) SB
      WST(3) SB
#undef LFA
#undef LFB
#undef MHALF
#undef WST
#undef SB
    }
    __syncthreads();
  }
}


DI void gemm_core_q(const bf16_t* Wt, const bf16_t* X, int K, f32x16 (&acc)[2], char* lds, int wv) {
  const int t = tid_opaque(wv), lane = t & 63, w = t >> 6, r = lane & 31, h = lane >> 5, wn = w & 3, wm = w >> 2;
  const int lrow = t >> 3, lpart = t & 7;
  const bf16_t* gw = Wt + (size_t)lrow * K + lpart * 8;
  const bf16_t* gx = X + (size_t)lrow * K + lpart * 8;
  char* stw = lds + lrow * 144 + lpart * 16;
  const char* wsp = lds + (wn * 64 + r) * 144 + h * 16;
  const char* xsp = lds + 36864 + (wm * 32 + r) * 144 + h * 16;
  u32x4 rw[4], rx;
  const int nk = K >> 6;
  __syncthreads();
#pragma unroll
  for (int i = 0; i < 4; ++i) rw[i] = *(const u32x4*)(gw + (size_t)(64 * i) * K);
  rx = *(const u32x4*)gx;
  for (int kt = 0; kt < nk; ++kt) {
#pragma unroll
    for (int i = 0; i < 4; ++i) *(u32x4*)(stw + i * 64 * 144) = rw[i];
    *(u32x4*)(stw + 36864) = rx;
    __syncthreads();
    if (kt + 1 < nk) {
#pragma unroll
      for (int i = 0; i < 4; ++i) rw[i] = *(const u32x4*)(gw + (size_t)(64 * i) * K + (kt + 1) * 64);
      rx = *(const u32x4*)(gx + (kt + 1) * 64);
    }
#pragma unroll
    for (int s = 0; s < 4; ++s) {
      const bf16x8 a0 = *(const bf16x8*)(wsp + s * 32);
      const bf16x8 a1 = *(const bf16x8*)(wsp + 32 * 144 + s * 32);
      const bf16x8 b0 = *(const bf16x8*)(xsp + s * 32);
      acc[0] = MFMA(a0, b0, acc[0]);
      acc[1] = MFMA(a1, b0, acc[1]);
    }
    __syncthreads();
  }
}

DI void lds4(char* dst, float a, float b, float c, float d) {
  u32x2 v = {pk2(a, b), pk2(c, d)};
  *(u32x2*)dst = v;
}
DI void p1_epi_block(const Params& p, char* ws, int layer, int S, int nt, int wn, int h, size_t m, f32x16& a0, f32x16& a1,
                     char* srow) {
  const int n64 = nt * 128 + wn * 64;
  const int pos = (int)m & (S - 1);
  if (nt < 5) {
#pragma unroll
    for (int g4 = 0; g4 < 4; ++g4) {
      lds4(srow + (8 * g4 + 4 * h) * 2, a0[4 * g4], a0[4 * g4 + 1], a0[4 * g4 + 2], a0[4 * g4 + 3]);
      lds4(srow + (32 + 8 * g4 + 4 * h) * 2, a1[4 * g4], a1[4 * g4 + 1], a1[4 * g4 + 2], a1[4 * g4 + 3]);
    }
  } else if (nt < 9 || (nt >= 45 && nt < 49)) {
#pragma unroll
    for (int g4 = 0; g4 < 4; ++g4) {
      lds4(srow + (8 * g4 + 4 * h) * 2, silu_f(a0[4 * g4]), silu_f(a0[4 * g4 + 1]), silu_f(a0[4 * g4 + 2]), silu_f(a0[4 * g4 + 3]));
      lds4(srow + (32 + 8 * g4 + 4 * h) * 2, silu_f(a1[4 * g4]), silu_f(a1[4 * g4 + 1]), silu_f(a1[4 * g4 + 2]), silu_f(a1[4 * g4 + 3]));
    }
  } else if (nt < 45) {
    const int c = n64 - 1152;
    const int kind = (c >> 9) % 3;
    if (kind < 2) {
      const float qs = kind == 0 ? 0.125f * LOG2E : 1.f;
      const float2* rt = (const float2*)(ws + OFF_ROPE64) + (size_t)pos * 32;
#pragma unroll
      for (int i = 0; i < 16; ++i) {
        const float2 cs = rt[crow(i, h)];
        const float x1 = a0[i], x2 = a1[i];
        a0[i] = (x1 * cs.x - x2 * cs.y) * qs;
        a1[i] = (x1 * cs.y + x2 * cs.x) * qs;
      }
    }
#pragma unroll
    for (int g4 = 0; g4 < 4; ++g4) {
      lds4(srow + (8 * g4 + 4 * h) * 2, a0[4 * g4], a0[4 * g4 + 1], a0[4 * g4 + 2], a0[4 * g4 + 3]);
      lds4(srow + (32 + 8 * g4 + 4 * h) * 2, a1[4 * g4], a1[4 * g4 + 1], a1[4 * g4 + 2], a1[4 * g4 + 3]);
    }
  } else if (nt < 65) {
    const int c = n64 - 6272;
    const float* bg = p.b_gate + layer * 2048 + c;
#pragma unroll
    for (int g4 = 0; g4 < 4; ++g4) {
      const int o = 8 * g4 + 4 * h;
      const float4 b0 = *(const float4*)(bg + o);
      const float4 b1 = *(const float4*)(bg + 32 + o);
      lds4(srow + (o) * 2, sigm_f(a0[4 * g4] + b0.x), sigm_f(a0[4 * g4 + 1] + b0.y), sigm_f(a0[4 * g4 + 2] + b0.z), sigm_f(a0[4 * g4 + 3] + b0.w));
      lds4(srow + (32 + o) * 2, sigm_f(a1[4 * g4] + b1.x), sigm_f(a1[4 * g4 + 1] + b1.y), sigm_f(a1[4 * g4 + 2] + b1.z), sigm_f(a1[4 * g4 + 3] + b1.w));
    }
  } else if (wn == 0) {
    const float2* rt = (const float2*)(ws + OFF_ROPE32) + (size_t)pos * 16;
#pragma unroll
    for (int i = 0; i < 8; ++i) {
      const float2 cs = rt[crow(i, h)];
      const float x1 = a0[i], x2 = a0[i + 8];
      a0[i] = x1 * cs.x - x2 * cs.y;
      a0[i + 8] = x1 * cs.y + x2 * cs.x;
    }
    bf16_t* dst = (bf16_t*)(ws + OFF_KPE) + m * 32;
#pragma unroll
    for (int g4 = 0; g4 < 4; ++g4) store4(dst + 8 * g4 + 4 * h, a0[4 * g4], a0[4 * g4 + 1], a0[4 * g4 + 2], a0[4 * g4 + 3]);
  }
}


template <int NROWS = 128>
DI void p1_copy_out(char* ws, int nt, int wn, size_t m0, const char* stage, int lane) {
  const int n64 = nt * 128 + wn * 64;
  bf16_t* dbase;
  int ld;
  if (nt < 3) { dbase = (bf16_t*)(ws + OFF_CQ) + n64; ld = 384; }
  else if (nt < 5) { dbase = (bf16_t*)(ws + OFF_CKV) + (n64 - 384); ld = 256; }
  else if (nt < 9) { dbase = (bf16_t*)(ws + OFF_ZM) + (n64 - 640); ld = 512; }
  else if (nt < 45) { dbase = (bf16_t*)(ws + OFF_DIL) + (n64 - 1152); ld = 4608; }
  else if (nt < 49) { dbase = (bf16_t*)(ws + OFF_ZD) + (n64 - 5760); ld = 512; }
  else if (nt < 65) { dbase = (bf16_t*)(ws + OFF_MG) + (n64 - 6272); ld = 2048; }
  else return;
  const int rr = lane >> 3, ch = lane & 7;
#pragma unroll
  for (int i = 0; i < NROWS / 8; ++i) {
    const int row = rr + 8 * i;
    const u32x4 v = *(const u32x4*)(stage + row * 144 + ch * 16);
    __builtin_nontemporal_store(v, (u32x4*)(dbase + (m0 + row) * ld + ch * 8));
  }
}

DI void stage_acc_bf16(f32x16 (&acc)[2][4], char* stage, int r, int h) {
#pragma unroll
  for (int mb = 0; mb < 4; ++mb) {
    char* srow = stage + (mb * 32 + r) * 144;
#pragma unroll
    for (int nb = 0; nb < 2; ++nb)
#pragma unroll
      for (int g4 = 0; g4 < 4; ++g4)
        lds4(srow + (nb * 32 + 8 * g4 + 4 * h) * 2, acc[nb][mb][4 * g4], acc[nb][mb][4 * g4 + 1], acc[nb][mb][4 * g4 + 2],
             acc[nb][mb][4 * g4 + 3]);
  }
}


DI void copy_rows128(const char* stage, bf16_t* dbase, int ld, int lane) {
  const int rr = lane >> 3, ch = lane & 7;
#pragma unroll
  for (int i = 0; i < 16; ++i) {
    const int row = rr + 8 * i;
    __builtin_nontemporal_store(*(const u32x4*)(stage + row * 144 + ch * 16), (u32x4*)(dbase + (size_t)row * ld + ch * 8));
  }
}

DI float lane_xor(float v, int lane, int o) {
  return __int_as_float(__builtin_amdgcn_ds_bpermute((lane ^ o) << 2, __float_as_int(v)));
}
DI float wave_sum(float v, int lane) {
#pragma unroll
  for (int o = 32; o > 0; o >>= 1) v += lane_xor(v, lane, o);
  return v;
}

template <int NCH>
DI float row_rs(const bf16_t* p, float invk) {
  float ss = 0.f;
#pragma unroll 1
  for (int c0 = 0; c0 < NCH; c0 += 4) {
    u32x4 v[4];
#pragma unroll
    for (int c = 0; c < 4; ++c) v[c] = *(const u32x4*)(p + (c0 + c) * 8);
#pragma unroll
    for (int c = 0; c < 4; ++c)
#pragma unroll
      for (int j = 0; j < 4; ++j) {
        const float a = bflo(v[c][j]), b = bfhi(v[c][j]);
        ss += a * a + b * b;
      }
  }
  ss += __shfl_xor(ss, 32);
  return rsqrtf(ss * invk + EPSN);
}

DI void transpose_tile(const float* src, int Nsrc, int K, bf16_t* dst, int k0, int n0, int mode, const float* rowscale,
                       char* lds, int wv) {
  const int tt = tid_opaque(wv), t = tt & 255;
  float* tl = (float*)(lds + (tt >> 8) * 16640);
#pragma unroll
  for (int i = 0; i < 16; ++i) {
    const int kk = (t >> 6) + 4 * i, nn = t & 63;
    const int n = n0 + nn;
    const int sc = mode ? (n < 640 ? n : (n < 8320 ? n + 32 : (n < 8352 ? n - 7680 : -1))) : n;
    float v = sc >= 0 ? src[(size_t)(k0 + kk) * Nsrc + sc] : 0.f;
    if (rowscale) v *= rowscale[k0 + kk];
    tl[nn * 65 + kk] = v;
  }
  __syncthreads();
  {
    const int nn = t >> 2, kp = (t & 3) * 16;
    const float* row = tl + nn * 65 + kp;
    u32x4 o0 = {pk2(row[0], row[1]), pk2(row[2], row[3]), pk2(row[4], row[5]), pk2(row[6], row[7])};
    u32x4 o1 = {pk2(row[8], row[9]), pk2(row[10], row[11]), pk2(row[12], row[13]), pk2(row[14], row[15])};
    bf16_t* d = dst + (size_t)(n0 + nn) * K + k0 + kp;
    *(u32x4*)d = o0;
    *(u32x4*)(d + 8) = o1;
  }
  __syncthreads();
}

DI void mod_item(const Params& p, int it, char* lds, int wv) {
  const int t = tid_opaque(wv);
  const int l = it / 48, chunk = it % 48;
  float* sc = (float*)lds;
  for (int e = t; e < 10240; e += NTHR) {
    const int s = e >> 10, k = e & 1023;
    const float c = s < 8 ? p.c_prompt[s * 1024 + k] : p.c_sample[(s - 8) * 1024 + k];
    sc[e] = c / (1.f + expf(-c));
  }
  __syncthreads();
  const int ks = t >> 6, col = chunk * 64 + (t & 63);
  float a0 = 0, a1 = 0, a2 = 0, a3 = 0, a4 = 0, a5 = 0, a6 = 0, a7 = 0, a8 = 0, a9 = 0;
  const float* wp = p.w_ada + (size_t)l * 1024 * 3072 + col;
#pragma unroll 4
  for (int k = ks * 128; k < ks * 128 + 128; ++k) {
    const float wv_ = wp[(size_t)k * 3072];
    a0 += sc[k] * wv_;
    a1 += sc[1024 + k] * wv_;
    a2 += sc[2048 + k] * wv_;
    a3 += sc[3072 + k] * wv_;
    a4 += sc[4096 + k] * wv_;
    a5 += sc[5120 + k] * wv_;
    a6 += sc[6144 + k] * wv_;
    a7 += sc[7168 + k] * wv_;
    a8 += sc[8192 + k] * wv_;
    a9 += sc[9216 + k] * wv_;
  }
  float* red = (float*)(lds + 40960);
  const int c6 = t & 63;
  red[(ks * 10 + 0) * 64 + c6] = a0;
  red[(ks * 10 + 1) * 64 + c6] = a1;
  red[(ks * 10 + 2) * 64 + c6] = a2;
  red[(ks * 10 + 3) * 64 + c6] = a3;
  red[(ks * 10 + 4) * 64 + c6] = a4;
  red[(ks * 10 + 5) * 64 + c6] = a5;
  red[(ks * 10 + 6) * 64 + c6] = a6;
  red[(ks * 10 + 7) * 64 + c6] = a7;
  red[(ks * 10 + 8) * 64 + c6] = a8;
  red[(ks * 10 + 9) * 64 + c6] = a9;
  __syncthreads();
  float* mod = (float*)(p.ws + OFF_MOD);
  for (int o = t; o < 640; o += NTHR) {
    const int s = o >> 6, c = o & 63;
    float v = 0.f;
#pragma unroll
    for (int q = 0; q < 8; ++q) v += red[(q * 10 + s) * 64 + c];
    const int cc = chunk * 64 + c;
    mod[(l * 10 + s) * 3072 + cc] = v + p.b_ada[l * 3072 + cc];
  }
  __syncthreads();
}

DI void phase0(const Params& p, char* lds, int wv) {
  constexpr int N_MOD = 96;
  constexpr int N_WIN = 2 * 16 * 132, N_WUQ = 2 * 6 * 12, N_WUKV = 2 * 4 * 16, N_WPA = 2 * 8 * 16, N_WOUT = 2 * 16 * 16;
  constexpr int N_TR = N_WIN + N_WUQ + N_WUKV + 2 * N_WPA + N_WOUT;
  constexpr int N_ROPE = (16384 * 32 + 16384 * 16) / NTHR;
  constexpr int TOTAL = N_MOD + N_TR / 2 + N_ROPE;
  for (int it = blockIdx.x; it < TOTAL; it += gridDim.x) {
    if (it < N_MOD) {
      mod_item(p, it, lds, wv);
    } else if (it < N_MOD + N_TR / 2) {
      int j = (it - N_MOD) * 2 + (tid_opaque(wv) >> 8);
      const float* src; bf16_t* dst; const float* rsc = nullptr;
      int Nsrc, K, k0, n0, mode = 0;
      if (j < N_WIN) {
        const int l = j / (16 * 132), rem = j % (16 * 132), kt = rem / 132, nt = rem % 132;
        src = p.w_in + (size_t)l * 1024 * 8352; Nsrc = 8352; K = 1024;
        dst = (bf16_t*)(p.ws + OFF_WIN) + (size_t)l * NPAD * 1024; k0 = kt * 64; n0 = nt * 64; mode = 1;
      } else if ((j -= N_WIN) < N_WUQ) {
        const int l = j / 72, rem = j % 72, kt = rem / 12, nt = rem % 12;
        src = p.w_uq + (size_t)l * 384 * 768; Nsrc = 768; K = 384;
        dst = (bf16_t*)(p.ws + OFF_WUQ) + (size_t)l * 768 * 384; k0 = kt * 64; n0 = nt * 64; rsc = p.g_cq + l * 384;
      } else if ((j -= N_WUQ) < N_WUKV) {
        const int l = j / 64, rem = j % 64, kt = rem / 16, nt = rem % 16;
        src = p.w_ukv + (size_t)l * 256 * 1024; Nsrc = 1024; K = 256;
        dst = (bf16_t*)(p.ws + OFF_WUKV) + (size_t)l * 1024 * 256; k0 = kt * 64; n0 = nt * 64; rsc = p.g_ckv + l * 256;
      } else if ((j -= N_WUKV) < 2 * N_WPA) {
        const int which = j / N_WPA;
        j %= N_WPA;
        const int l = j / 128, rem = j % 128, kt = rem / 16, nt = rem % 16;
        src = (which ? p.w_pb : p.w_pa) + (size_t)l * 512 * 1024; Nsrc = 1024; K = 512;
        dst = (bf16_t*)(p.ws + (which ? OFF_WPB : OFF_WPA)) + (size_t)l * 1024 * 512; k0 = kt * 64; n0 = nt * 64;
      } else {
        j -= 2 * N_WPA;
        const int l = j / 256, rem = j % 256, kt = rem / 16, nt = rem % 16;
        src = p.w_out + (size_t)l * 1024 * 1024; Nsrc = 1024; K = 1024;
        dst = (bf16_t*)(p.ws + OFF_WOUT) + (size_t)l * 1024 * 1024; k0 = kt * 64; n0 = nt * 64;
      }
      transpose_tile(src, Nsrc, K, dst, k0, n0, mode, rsc, lds, wv);
    } else {
      const int idx = (it - N_MOD - N_TR / 2) * NTHR + tid_opaque(wv);
      int pos, f, d;
      float2* dst;
      if (idx < 16384 * 32) {
        pos = idx >> 5; f = idx & 31; d = 64;
        dst = (float2*)(p.ws + OFF_ROPE64) + idx;
      } else {
        const int i2 = idx - 16384 * 32;
        pos = i2 >> 4; f = i2 & 15; d = 32;
        dst = (float2*)(p.ws + OFF_ROPE32) + i2;
      }
      const float inv = exp2f(-(float)(2 * f) / (float)d * 13.287712379549449f);
      const float ang = (float)pos * inv;
      const double a = (double)ang;
      const double kk = rint(a * 0.15915494309189535);
      const float rr = (float)(a - kk * 6.283185307179586);
      *dst = make_float2(__cosf(rr), __sinf(rr));
    }
  }
}

DI void mla_item(const Params& p, int tokbase, int S, int head, int q0, char* lds, int wv) {
  const int t = tid_opaque(wv), lane = t & 63, w = t >> 6, r = lane & 31, h = lane >> 5;
  const bf16_t* qm = (const bf16_t*)(p.ws + OFF_QM);
  const bf16_t* kn = (const bf16_t*)(p.ws + OFF_KN);
  const bf16_t* kpe = (const bf16_t*)(p.ws + OFF_KPE);
  const bf16_t* vm = (const bf16_t*)(p.ws + OFF_VM);
  bf16x8 bq[2][6];
#pragma unroll
  for (int qb = 0; qb < 2; ++qb) {
    const bf16_t* qp = qm + (size_t)(tokbase + q0 + w * 64 + qb * 32 + r) * 768 + head * 96 + h * 8;
#pragma unroll
    for (int s = 0; s < 6; ++s) bq[qb][s] = *(const bf16x8*)(qp + s * 16);
  }
  f32x16 O[2][2];
#pragma unroll
  for (int a = 0; a < 2; ++a)
#pragma unroll
    for (int b = 0; b < 2; ++b) zero16(O[a][b]);
  float mrun[2] = {-1e30f, -1e30f}, lrun[2] = {0.f, 0.f};

  const bool lo = t < 256;
  const int key8 = t >> 3, part8 = t & 7;
  const size_t goff = (size_t)(tokbase + key8) * 512 + head * 64 + part8 * 8;
  const bf16_t* g2 = kpe + (size_t)(tokbase + ((t & 255) >> 2)) * 32 + (t & 3) * 8;
  char* d0 = lds + key8 * 208 + part8 * 16;
  char* d1 = lds + 13312 + key8 * 144 + part8 * 16;
  char* d2 = lds + ((t & 255) >> 2) * 208 + 128 + (t & 3) * 16;
  u32x4 st[3];
  st[0] = *(const u32x4*)(kn + goff); st[1] = *(const u32x4*)(vm + goff);
  if (lo) st[2] = *(const u32x4*)g2;
  *(u32x4*)d0 = st[0]; *(u32x4*)d1 = st[1];
  if (lo) *(u32x4*)d2 = st[2];
  __syncthreads();
  const int i16 = lane & 15, tq = i16 >> 2, tp = i16 & 3, tblk = (lane >> 4) & 1;
  const int voff = 13312 + (4 * h + tq) * 144 + 32 * tblk + 8 * tp;
  const int koff = r * 208 + h * 16;
  const int nt = S >> 6;
  for (int kt = 0; kt < nt; ++kt) {
    const bool more = kt + 1 < nt;
    const char* buf = lds + (kt & 1) * 22528;
    bf16x8 kf[6];
    {
      const char* kp = buf + koff;
#pragma unroll
      for (int s = 0; s < 6; ++s) kf[s] = *(const bf16x8*)(kp + s * 32);
    }
    __builtin_amdgcn_sched_barrier(0);
#pragma unroll
    for (int kb = 0; kb < 2; ++kb) {
      f32x16 sc[2];
      zero16(sc[0]); zero16(sc[1]);
#pragma unroll
      for (int s = 0; s < 6; ++s) {
        sc[0] = MFMA(kf[s], bq[0][s], sc[0]);
        sc[1] = MFMA(kf[s], bq[1][s], sc[1]);
      }
      __builtin_amdgcn_sched_barrier(0);
      bf16x8 vf[2][2];
      {
        const char* vp = buf + voff + kb * 32 * 144;
#pragma unroll
        for (int s = 0; s < 2; ++s)
#pragma unroll
          for (int dvb = 0; dvb < 2; ++dvb)
            vf[s][dvb] = tr_frag(vp + (16 * s) * 144 + dvb * 64, vp + (16 * s + 8) * 144 + dvb * 64);
      }
      if (kb == 0) {
        const char* kp = buf + koff + 32 * 208;
#pragma unroll
        for (int s = 0; s < 6; ++s) kf[s] = *(const bf16x8*)(kp + s * 32);
      }
      __builtin_amdgcn_sched_barrier(0);
      bf16x8 pf[2][2];
#pragma unroll
      for (int qb = 0; qb < 2; ++qb) {
        const f32x2 m2 = {mrun[qb], mrun[qb]};
        f32x2 ls2 = {0.f, 0.f};
        u32x4 pk0, pk1;
#pragma unroll
        for (int i = 0; i < 16; i += 2) {
          f32x2 v = {sc[qb][i], sc[qb][i + 1]};
          v = v - m2;
          v[0] = ex2(v[0]);
          v[1] = ex2(v[1]);
          ls2 = ls2 + v;
          if (i < 8) pk0[i >> 1] = pk2(v[0], v[1]);
          else pk1[(i - 8) >> 1] = pk2(v[0], v[1]);
        }
        float ls = ls2[0] + ls2[1];
        if (__builtin_amdgcn_ballot_w64(!(ls < 2048.f)) != 0) {
          float mx = fmaxf(fmaxf(sc[qb][0], sc[qb][1]), sc[qb][2]);
#pragma unroll
          for (int i = 3; i < 15; i += 2) mx = fmaxf(fmaxf(mx, sc[qb][i]), sc[qb][i + 1]);
          mx = fmaxf(mx, sc[qb][15]);
          const float mxx = fmaxf(mx, lane_xor(mx, lane, 32));
          const float mnew = fmaxf(mrun[qb], mxx);
          const float alpha = ex2(mrun[qb] - mnew);
          mrun[qb] = mnew;
          lrun[qb] *= alpha;
#pragma unroll
          for (int i = 0; i < 16; ++i) {
            O[0][qb][i] *= alpha;
            O[1][qb][i] *= alpha;
          }
          ls = 0.f;
#pragma unroll
          for (int i = 0; i < 16; i += 2) {
            const float e0 = ex2(sc[qb][i] - mnew), e1 = ex2(sc[qb][i + 1] - mnew);
            ls += e0 + e1;
            if (i < 8) pk0[i >> 1] = pk2(e0, e1);
            else pk1[(i - 8) >> 1] = pk2(e0, e1);
          }
        }
        lrun[qb] += ls;
        pf[qb][0] = __builtin_bit_cast(bf16x8, pk0);
        pf[qb][1] = __builtin_bit_cast(bf16x8, pk1);
      }
      __builtin_amdgcn_sched_barrier(0);
#pragma unroll
      for (int s = 0; s < 2; ++s) {
#pragma unroll
        for (int dvb = 0; dvb < 2; ++dvb) {
          O[dvb][0] = MFMA(vf[s][dvb], pf[0][s], O[dvb][0]);
          O[dvb][1] = MFMA(vf[s][dvb], pf[1][s], O[dvb][1]);
        }
      }
      __builtin_amdgcn_sched_barrier(0);
      if (kb == 0 && more) {
        const size_t o5 = goff + (size_t)(kt + 1) * 64 * 512;
        st[0] = *(const u32x4*)(kn + o5); st[1] = *(const u32x4*)(vm + o5);
        if (lo) st[2] = *(const u32x4*)(g2 + (size_t)(kt + 1) * 64 * 32);
        __builtin_amdgcn_sched_barrier(0);
      }
    }
    if (more) {
      const int bo = ((kt + 1) & 1) * 22528;
      *(u32x4*)(d0 + bo) = st[0]; *(u32x4*)(d1 + bo) = st[1];
      if (lo) *(u32x4*)(d2 + bo) = st[2];
    }
    __syncthreads();
  }
  const bf16_t* zm = (const bf16_t*)(p.ws + OFF_ZM);
  bf16_t* om = (bf16_t*)(p.ws + OFF_OM);
#pragma unroll
  for (int qb = 0; qb < 2; ++qb) {
    const float l = lrun[qb] + lane_xor(lrun[qb], lane, 32);
    const float inv = 1.f / l;
    const size_t tok = (size_t)(tokbase + q0 + w * 64 + qb * 32 + r);
#pragma unroll
    for (int dvb = 0; dvb < 2; ++dvb)
#pragma unroll
      for (int g4 = 0; g4 < 4; ++g4) {
        const int col = head * 64 + dvb * 32 + 8 * g4 + 4 * h;
        const u32x2 z = *(const u32x2*)(zm + tok * 512 + col);
        store4(om + tok * 512 + col, O[dvb][qb][4 * g4] * inv * bflo(z[0]), O[dvb][qb][4 * g4 + 1] * inv * bfhi(z[0]),
               O[dvb][qb][4 * g4 + 2] * inv * bflo(z[1]), O[dvb][qb][4 * g4 + 3] * inv * bfhi(z[1]));
      }
  }
}

DI void dil_item(const Params& p, int tokbase, int S, int head, int g, int dil, int cls, int np, char* lds, int wv) {
  const int t = tid_opaque(wv), lane = t & 63, w = t >> 6, r = lane & 31, h = lane >> 5;
  const bf16_t* db = (const bf16_t*)(p.ws + OFF_DIL);
  const int L = S / dil;
  const int l0 = np * 256 - 64;
  {
    const int part = t & 7;
#pragma unroll
    for (int pass = 0; pass < 2; ++pass) {
      u32x4 v[6];
#pragma unroll
      for (int i = 0; i < 6; ++i) {
        const int kk = (t >> 3) + 64 * i;
        const int l = l0 + kk;
        const bool ok = (unsigned)l < (unsigned)L;
        const size_t tok = (size_t)(tokbase + (ok ? l : 0) * dil + cls);
        u32x4 x = *(const u32x4*)(db + tok * 4608 + (3 * g + 1 + pass) * 512 + head * 64 + part * 8);
        if (!ok) x = (u32x4){0u, 0u, 0u, 0u};
        v[i] = x;
      }
#pragma unroll
      for (int i = 0; i < 6; ++i) {
        const int kk = (t >> 3) + 64 * i;
        *(u32x4*)(lds + pass * 55296 + kk * 144 + part * 16) = v[i];
      }
    }
  }
  __syncthreads();
  const int lq = np * 256 + w * 32 + r;
  const size_t tokq = (size_t)(tokbase + lq * dil + cls);
  bf16x8 bq[4];
  {
    const bf16_t* qp = db + tokq * 4608 + (3 * g) * 512 + head * 64 + h * 8;
#pragma unroll
    for (int s = 0; s < 4; ++s) bq[s] = *(const bf16x8*)(qp + s * 16);
  }
  f32x16 sc[5];
#pragma unroll
  for (int kb = 0; kb < 5; ++kb) {
    zero16(sc[kb]);
    const char* kp = lds + (w * 32 + kb * 32 + r) * 144 + h * 16;
#pragma unroll
    for (int s = 0; s < 4; ++s) {
      bf16x8 ka = *(const bf16x8*)(kp + s * 32);
      sc[kb] = MFMA(ka, bq[s], sc[kb]);
    }
  }
  float mx = -1e30f;
#pragma unroll
  for (int kb = 0; kb < 5; ++kb)
#pragma unroll
    for (int i = 0; i < 16; ++i) {
      const int c = crow(i, h);
      const int lk = l0 + w * 32 + kb * 32 + c;
      bool ok = (unsigned)lk < (unsigned)L;
      if (kb == 0) ok = ok && (c >= r);
      if (kb == 4) ok = ok && (c <= r);
      const float v = ok ? sc[kb][i] : -1e30f;
      sc[kb][i] = v;
      mx = fmaxf(mx, v);
    }
  mx = fmaxf(mx, lane_xor(mx, lane, 32));
  float ls = 0.f;
#pragma unroll
  for (int kb = 0; kb < 5; ++kb)
#pragma unroll
    for (int i = 0; i < 16; ++i) {
      const float pv = ex2(sc[kb][i] - mx);
      sc[kb][i] = pv;
      ls += pv;
    }
  ls += lane_xor(ls, lane, 32);
  f32x16 O[2];
  zero16(O[0]); zero16(O[1]);
  const int i16 = lane & 15, tq = i16 >> 2, tp = i16 & 3, tblk = (lane >> 4) & 1;
  const char* vbase = lds + 55296 + (w * 32 + 4 * h + tq) * 144 + 32 * tblk + 8 * tp;
#pragma unroll
  for (int kb = 0; kb < 5; ++kb) {
    bf16x8 pf0 = pack_step<0>(sc[kb]);
    bf16x8 pf1 = pack_step<1>(sc[kb]);
#pragma unroll
    for (int dvb = 0; dvb < 2; ++dvb) {
      bf16x8 v0 = tr_frag(vbase + (kb * 32) * 144 + dvb * 64, vbase + (kb * 32 + 8) * 144 + dvb * 64);
      O[dvb] = MFMA(v0, pf0, O[dvb]);
      bf16x8 v1 = tr_frag(vbase + (kb * 32 + 16) * 144 + dvb * 64, vbase + (kb * 32 + 24) * 144 + dvb * 64);
      O[dvb] = MFMA(v1, pf1, O[dvb]);
    }
  }
  const float inv = 1.f / ls;
  bf16_t* og = (bf16_t*)(p.ws + OFF_OG) + (size_t)g * TR * 512;
#pragma unroll
  for (int dvb = 0; dvb < 2; ++dvb)
#pragma unroll
    for (int g4 = 0; g4 < 4; ++g4) {
      const int col = head * 64 + dvb * 32 + 8 * g4 + 4 * h;
      store4(og + tokq * 512 + col, O[dvb][4 * g4] * inv, O[dvb][4 * g4 + 1] * inv, O[dvb][4 * g4 + 2] * inv,
             O[dvb][4 * g4 + 3] * inv);
    }
  if (h == 0) {
    float* lse = (float*)(p.ws + OFF_LSE);
    lse[((size_t)g * TR + tokq) * 8 + head] = mx + __log2f(ls);
  }
  __syncthreads();
}


DI void h_phase(const Params& p, int layer, int rd, int wv) {
  const int t = tid_opaque(wv), lane = t & 63, w = t >> 6;
  char* ws = ptr_opaque(p.ws);
  const float* xin = layer == 0 ? (rd < 2 ? p.x_prompt + (size_t)rd * TR * 1024 : p.x_sample + (size_t)(rd - 2) * TR * 1024)
                                : p.out + (size_t)rd * TR * 1024;
  const int lgS = rd < 2 ? 12 : 14;
  const int seq0 = rd < 2 ? rd * 4 : 8 + (rd - 2);
  const float* modl = (const float*)(ws + OFF_MOD) + (size_t)layer * 10 * 3072;
  bf16_t* hb = (bf16_t*)(ws + OFF_H);
  const float* gn = p.g_norm + layer * 1024;
  for (int row0 = (blockIdx.x * 8 + w) * 4; row0 < TR; row0 += gridDim.x * 32) {
    float4 v[4][4];
    float ss[4] = {0.f, 0.f, 0.f, 0.f};
#pragma unroll
    for (int u = 0; u < 4; ++u) {
      const float4* xr = (const float4*)(xin + (size_t)(row0 + u) * 1024);
#pragma unroll
      for (int j = 0; j < 4; ++j) {
        { const f32x4v q_ = __builtin_nontemporal_load((const f32x4v*)(xr + lane + 64 * j)); v[u][j] = make_float4(q_[0], q_[1], q_[2], q_[3]); }
        ss[u] += v[u][j].x * v[u][j].x + v[u][j].y * v[u][j].y + v[u][j].z * v[u][j].z + v[u][j].w * v[u][j].w;
      }
    }
    const float* md = modl + (seq0 + (row0 >> lgS)) * 3072;
#pragma unroll
    for (int u = 0; u < 4; ++u) {
      const float rs = rsqrtf(wave_sum(ss[u], lane) * (1.f / 1024.f) + EPSN);
#pragma unroll
      for (int j = 0; j < 4; ++j) {
        const int n = (lane + 64 * j) * 4;
        const float4 g = *(const float4*)(gn + n);
        const float4 sh = *(const float4*)(md + n);
        const float4 sc = *(const float4*)(md + 1024 + n);
        store4(hb + (size_t)(row0 + u) * 1024 + n, v[u][j].x * rs * g.x * (1.f + sc.x) + sh.x, v[u][j].y * rs * g.y * (1.f + sc.y) + sh.y,
               v[u][j].z * rs * g.z * (1.f + sc.z) + sh.z, v[u][j].w * rs * g.w * (1.f + sc.w) + sh.w);
      }
    }
  }
}

__global__ void __launch_bounds__(512, 2) mega_kernel(Params p) {
  extern __shared__ __attribute__((aligned(16))) char lds[];
  cg::grid_group grid = cg::this_grid();

  const int wv = __builtin_amdgcn_readfirstlane((int)(threadIdx.x >> 6));
  __shared__ uint4 xb_words;
  if (threadIdx.x == 0) xb_words = make_uint4(0u, 0u, 0u, 0u);
  __syncthreads();
  const XcdBarrier xb = xcd_barrier_post((unsigned*)(p.ws + OFF_BAR), (volatile LAS unsigned*)&xb_words);

  phase0(p, lds, wv);
  grid.sync();
  h_phase(p, 0, 0, wv);
  xcd_barrier(xb, wv, p.ws);

  for (int layer = 0; layer < 2; ++layer) {
    for (int rd = 0; rd < 4; ++rd) {
      const float* xin = layer == 0 ? (rd < 2 ? p.x_prompt + (size_t)rd * TR * 1024 : p.x_sample + (size_t)(rd - 2) * TR * 1024)
                                    : p.out + (size_t)rd * TR * 1024;
      float* xout = p.out + (size_t)rd * TR * 1024;
      const int S = rd < 2 ? 4096 : 16384;
      const int lgS = rd < 2 ? 12 : 14;
      const int seq0 = rd < 2 ? rd * 4 : 8 + (rd - 2);

      {
        char* ws = ptr_opaque(p.ws);
        const bf16_t* wt = (const bf16_t*)(ws + OFF_WIN) + (size_t)layer * NPAD * 1024;
        const bf16_t* hb = (const bf16_t*)(ws + OFF_H);
        for (int j = 0, mt, nt; xcd_tile256_p1(j, mt, nt); ++j) {
          f32x16 acc[2][4];
#pragma unroll
          for (int a_ = 0; a_ < 2; ++a_)
#pragma unroll
            for (int b_ = 0; b_ < 4; ++b_) zero16(acc[a_][b_]);
          gemm_core256(wt + (size_t)nt * 256 * 1024, hb + (size_t)mt * 256 * 1024, 1024, acc, lds, wv);
          {
            const int t2 = tid_opaque(wv), l2 = t2 & 63, w2 = t2 >> 6, r2 = l2 & 31, h2 = l2 >> 5, wn2 = w2 & 3, wm2 = w2 >> 2;
            char* ws2 = ptr_opaque(p.ws);
            char* stage = lds + w2 * 18432;
#pragma unroll
            for (int mb = 0; mb < 4; ++mb)
              p1_epi_block(p, ws2, layer, S, nt * 2 + (wn2 >> 1), wn2 & 1, h2, (size_t)(mt * 256 + wm2 * 128 + mb * 32 + r2), acc[0][mb],
                           acc[1][mb], stage + (mb * 32 + r2) * 144);
            p1_copy_out(ws2, nt * 2 + (wn2 >> 1), wn2 & 1, (size_t)(mt * 256 + wm2 * 128), stage, l2);
          }
        }
        {
          int x, q, nq, mper;
          vxcd(x, q, nq, mper);
          for (int e = q; e < mper * 4; e += nq) {
            const int nt = 32;
            const int m0t = (x * mper + (e >> 2)) * 256 + (e & 3) * 64;
            f32x16 acc[2];
            zero16(acc[0]); zero16(acc[1]);
            gemm_core_q(wt + (size_t)nt * 256 * 1024, hb + (size_t)m0t * 1024, 1024, acc, lds, wv);
            const int t2 = tid_opaque(wv), l2 = t2 & 63, w2 = t2 >> 6, r2 = l2 & 31, h2 = l2 >> 5, wn2 = w2 & 3, wm2 = w2 >> 2;
            char* ws2 = ptr_opaque(p.ws);
            char* stage = lds + w2 * 18432;
            p1_epi_block(p, ws2, layer, S, nt * 2 + (wn2 >> 1), wn2 & 1, h2, (size_t)(m0t + wm2 * 32 + r2), acc[0], acc[1],
                         stage + r2 * 144);
            p1_copy_out<32>(ws2, nt * 2 + (wn2 >> 1), wn2 & 1, (size_t)(m0t + wm2 * 32), stage, l2);
          }
        }
      }
      xcd_barrier(xb, wv, p.ws);

      {
        char* ws = ptr_opaque(p.ws);
        for (int j = 0, mt, nt; xcd_tile256(j, 3, mt, nt); ++j) {
          f32x16 acc[2][4];
#pragma unroll
          for (int a_ = 0; a_ < 2; ++a_)
#pragma unroll
            for (int b_ = 0; b_ < 4; ++b_) zero16(acc[a_][b_]);
          {
            const bf16_t* cq = (const bf16_t*)(ws + OFF_CQ);
          {
            __syncthreads();
            const int t0 = tid_opaque(wv), row = t0 >> 1, half = t0 & 1;
            const bf16_t* rp = cq + (size_t)(mt * 256 + row) * 384 + half * (384 / 2);
            float ss = 0.f;
#pragma unroll 1
            for (int c0 = 0; c0 < 384 / 16; c0 += 8) {
              u32x4 v[8];
#pragma unroll
              for (int c = 0; c < 8; ++c) v[c] = *(const u32x4*)(rp + (c0 + c) * 8);
#pragma unroll
              for (int c = 0; c < 8; ++c)
#pragma unroll
                for (int jj = 0; jj < 4; ++jj) {
                  const float a = bflo(v[c][jj]), b = bfhi(v[c][jj]);
                  ss += a * a + b * b;
                }
            }
            ss += lane_xor(ss, t0 & 63, 1);
            if (!half) ((float*)(lds + 147456))[row] = rsqrtf(ss * (1.f / 384) + EPSN);
          }
            gemm_core256((const bf16_t*)(ws + OFF_WUQ) + (size_t)layer * 768 * 384 + (size_t)nt * 256 * 384,
                         cq + (size_t)mt * 256 * 384, 384, acc, lds, wv);
            const int t2 = tid_opaque(wv), l2 = t2 & 63, w2 = t2 >> 6, r = l2 & 31, h = l2 >> 5, wn = w2 & 3, wm = w2 >> 2;
            const float2* rope32 = (const float2*)(ptr_opaque(p.ws) + OFF_ROPE32);
            const float qs = 0.10206207261596575f * LOG2E;
#pragma unroll
            for (int mb = 0; mb < 4; ++mb) {
              __builtin_amdgcn_sched_barrier(0);
              const size_t m = (size_t)(mt * 256 + wm * 128 + mb * 32 + r);
              const int pos = (int)m & (S - 1);
              const float rs = ((const float*)(lds + 147456))[wm * 128 + mb * 32 + r] * qs;
              const float2* rt = rope32 + (size_t)pos * 16;
#pragma unroll
              for (int nb = 0; nb < 2; ++nb) {
                const int c0 = nt * 256 + wn * 64 + nb * 32;
                if (c0 % 96 == 64) {
#pragma unroll
                  for (int i = 0; i < 8; ++i) {
                    const float2 cs = rt[crow(i, h)];
                    const float x1 = acc[nb][mb][i], x2 = acc[nb][mb][i + 8];
                    acc[nb][mb][i] = x1 * cs.x - x2 * cs.y;
                    acc[nb][mb][i + 8] = x1 * cs.y + x2 * cs.x;
                  }
                }
                char* srow = lds + w2 * 18432 + (mb * 32 + r) * 144 + nb * 64;
#pragma unroll
                for (int g4 = 0; g4 < 4; ++g4)
                  lds4(srow + (8 * g4 + 4 * h) * 2, acc[nb][mb][4 * g4] * rs, acc[nb][mb][4 * g4 + 1] * rs, acc[nb][mb][4 * g4 + 2] * rs,
                       acc[nb][mb][4 * g4 + 3] * rs);
              }
            }
            copy_rows128(lds + w2 * 18432, (bf16_t*)(ws + OFF_QM) + (size_t)(mt * 256 + wm * 128) * 768 + nt * 256 + wn * 64, 768, l2);
          }
        }
        for (int j = 0, mt, nt; xcd_tile256(j, 4, mt, nt); ++j) {
          f32x16 acc[2][4];
#pragma unroll
          for (int a_ = 0; a_ < 2; ++a_)
#pragma unroll
            for (int b_ = 0; b_ < 4; ++b_) zero16(acc[a_][b_]);
          {
            const bf16_t* ckv = (const bf16_t*)(ws + OFF_CKV);
          {
            __syncthreads();
            const int t0 = tid_opaque(wv), row = t0 >> 1, half = t0 & 1;
            const bf16_t* rp = ckv + (size_t)(mt * 256 + row) * 256 + half * (256 / 2);
            float ss = 0.f;
#pragma unroll 1
            for (int c0 = 0; c0 < 256 / 16; c0 += 8) {
              u32x4 v[8];
#pragma unroll
              for (int c = 0; c < 8; ++c) v[c] = *(const u32x4*)(rp + (c0 + c) * 8);
#pragma unroll
              for (int c = 0; c < 8; ++c)
#pragma unroll
                for (int jj = 0; jj < 4; ++jj) {
                  const float a = bflo(v[c][jj]), b = bfhi(v[c][jj]);
                  ss += a * a + b * b;
                }
            }
            ss += lane_xor(ss, t0 & 63, 1);
            if (!half) ((float*)(lds + 147456))[row] = rsqrtf(ss * (1.f / 256) + EPSN);
          }
            gemm_core256((const bf16_t*)(ws + OFF_WUKV) + (size_t)layer * 1024 * 256 + (size_t)nt * 256 * 256,
                         ckv + (size_t)mt * 256 * 256, 256, acc, lds, wv);
            const int t2 = tid_opaque(wv), l2 = t2 & 63, w2 = t2 >> 6, r = l2 & 31, h = l2 >> 5, wn = w2 & 3, wm = w2 >> 2;
            const int c64 = nt * 256 + wn * 64;
            const int hd = c64 >> 7, isv = (c64 >> 6) & 1;
#pragma unroll
            for (int mb = 0; mb < 4; ++mb) {
              __builtin_amdgcn_sched_barrier(0);
              const size_t m = (size_t)(mt * 256 + wm * 128 + mb * 32 + r);
              const float rs = ((const float*)(lds + 147456))[wm * 128 + mb * 32 + r];
              char* srow = lds + w2 * 18432 + (mb * 32 + r) * 144;
#pragma unroll
              for (int nb = 0; nb < 2; ++nb)
#pragma unroll
                for (int g4 = 0; g4 < 4; ++g4)
                  lds4(srow + (nb * 32 + 8 * g4 + 4 * h) * 2, acc[nb][mb][4 * g4] * rs, acc[nb][mb][4 * g4 + 1] * rs,
                       acc[nb][mb][4 * g4 + 2] * rs, acc[nb][mb][4 * g4 + 3] * rs);
            }
            copy_rows128(lds + w2 * 18432, (bf16_t*)(ws + (isv ? OFF_VM : OFF_KN)) + (size_t)(mt * 256 + wm * 128) * 512 + hd * 64, 512, l2);
          }
        }
      }
      xcd_barrier(xb, wv, p.ws);

      {
        const int nseq = TR >> lgS;
        const int nqb = S >> 9;
        const int per_x = nseq;
        for (int it = blockIdx.x; it < 256 + 1536; it += gridDim.x) {
          if (it < 256) {
            const int x = it & 7, j = it >> 3;
            const int pair = x * per_x + j / nqb, qb = j % nqb;
            const int sl = pair >> 3, head = pair & 7;
            mla_item(p, sl << lgS, S, head, qb * 512, lds, wv);
          } else {
            const int j = it - 256;
            const int g = j >> 9, jj = j & 511;
            const int head = jj & 7, blk = jj >> 3;
            const int bps = S >> 8;
            const int sl = blk / bps, b2 = blk % bps;
            const int dil = g == 0 ? 1 : (g == 1 ? 4 : 16);
            const int bpc = bps / dil;
            const int cls = b2 / bpc, np = b2 % bpc;
            dil_item(p, sl << lgS, S, head, g, dil, cls, np, lds, wv);
          }
        }
      }
      xcd_barrier(xb, wv, p.ws);

      {
        const int t = tid_opaque(wv), lane = t & 63, w = t >> 6, r = lane & 31, h = lane >> 5, wn = w & 1, wm = w >> 1;
        char* ws = ptr_opaque(p.ws);
        const float* modl = (const float*)(ws + OFF_MOD) + (size_t)layer * 10 * 3072;
        (void)t; (void)lane; (void)w; (void)r; (void)h; (void)wn; (void)wm; (void)modl;
        const float* lse = (const float*)(ws + OFF_LSE);
        const bf16_t* og = (const bf16_t*)(ws + OFF_OG);
        const bf16_t* zd = (const bf16_t*)(ws + OFF_ZD);
        bf16_t* od = (bf16_t*)(ws + OFF_OD);
        for (int idx0 = blockIdx.x * NTHR + t; idx0 < TR * 64; idx0 += gridDim.x * NTHR * 4) {
#pragma unroll
          for (int u = 0; u < 4; ++u) {
            const int idx = idx0 + u * gridDim.x * NTHR;
            if (idx >= TR * 64) break;
          const size_t tok = (size_t)(idx >> 6);
          const int hp = idx & 63, head = hp >> 3;
          const float l0 = lse[tok * 8 + head], l1 = lse[((size_t)TR + tok) * 8 + head], l2 = lse[((size_t)2 * TR + tok) * 8 + head];
          const float mx = fmaxf(l0, fmaxf(l1, l2));
          float w0 = ex2(l0 - mx), w1 = ex2(l1 - mx), w2 = ex2(l2 - mx);
          const float inv = 1.f / (w0 + w1 + w2);
          w0 *= inv; w1 *= inv; w2 *= inv;
          const size_t e = tok * 512 + hp * 8;
          const u32x4 a = __builtin_nontemporal_load((const u32x4*)(og + e)),
                      b = __builtin_nontemporal_load((const u32x4*)(og + (size_t)TR * 512 + e)),
                      c = __builtin_nontemporal_load((const u32x4*)(og + (size_t)2 * TR * 512 + e)),
                      z = __builtin_nontemporal_load((const u32x4*)(zd + e));
          u32x4 o;
#pragma unroll
          for (int j = 0; j < 4; ++j) {
            const float lo = (w0 * bflo(a[j]) + w1 * bflo(b[j]) + w2 * bflo(c[j])) * bflo(z[j]);
            const float hi = (w0 * bfhi(a[j]) + w1 * bfhi(b[j]) + w2 * bfhi(c[j])) * bfhi(z[j]);
            o[j] = pk2(lo, hi);
          }
          *(u32x4*)(od + e) = o;
          }
        }
      }
      xcd_barrier(xb, wv, p.ws);

      {
        char* ws = ptr_opaque(p.ws);
        for (int j = 0, mt, nt; xcd_tile256(j, 4, mt, nt); ++j) {
          f32x16 acc[2][4];
#pragma unroll
          for (int a_ = 0; a_ < 2; ++a_)
#pragma unroll
            for (int b_ = 0; b_ < 4; ++b_) zero16(acc[a_][b_]);
          gemm_core256((const bf16_t*)(ws + OFF_WPA) + (size_t)layer * 1024 * 512 + (size_t)nt * 256 * 512,
                       (const bf16_t*)(ws + OFF_OM) + (size_t)mt * 256 * 512, 512, acc, lds, wv);
          {
            const int t2 = tid_opaque(wv), l2 = t2 & 63, w2 = t2 >> 6, r = l2 & 31, h = l2 >> 5, wn = w2 & 3, wm = w2 >> 2;
            char* stage = lds + w2 * 18432;
            stage_acc_bf16(acc, stage, r, h);
            bf16_t* t1 = (bf16_t*)(ptr_opaque(p.ws) + OFF_T1) + (size_t)(mt * 256 + wm * 128) * 1024 + nt * 256 + wn * 64;
            const int rr = l2 >> 3, ch = l2 & 7;
#pragma unroll
            for (int i = 0; i < 16; ++i) {
              const int row = rr + 8 * i;
              *(u32x4*)(t1 + (size_t)row * 1024 + ch * 8) = *(const u32x4*)(stage + row * 144 + ch * 16);
            }
          }
#pragma unroll
          for (int a_ = 0; a_ < 2; ++a_)
#pragma unroll
            for (int b_ = 0; b_ < 4; ++b_) zero16(acc[a_][b_]);
          gemm_core256((const bf16_t*)(ws + OFF_WPB) + (size_t)layer * 1024 * 512 + (size_t)nt * 256 * 512,
                       (const bf16_t*)(ws + OFF_OD) + (size_t)mt * 256 * 512, 512, acc, lds, wv);
          {
            const int t2 = tid_opaque(wv), l2 = t2 & 63, w2 = t2 >> 6, r = l2 & 31, h = l2 >> 5, wn = w2 & 3, wm = w2 >> 2;
            char* stage = lds + w2 * 18432;
            stage_acc_bf16(acc, stage, r, h);
            char* ws2 = ptr_opaque(p.ws);
            const size_t m0 = (size_t)(mt * 256 + wm * 128);
            const int n0 = nt * 256 + wn * 64;
            const bf16_t* t1 = (const bf16_t*)(ws2 + OFF_T1) + m0 * 1024 + n0;
            const bf16_t* mg = (const bf16_t*)(ws2 + OFF_MG) + m0 * 2048 + n0;
            bf16_t* tb = (bf16_t*)(ws2 + OFF_TB) + m0 * 1024 + n0;
            const int rr = l2 >> 3, ch = l2 & 7;
#pragma unroll 4
            for (int i = 0; i < 16; ++i) {
              const int row = rr + 8 * i;
              const u32x4 a2 = *(const u32x4*)(stage + row * 144 + ch * 16);
              const u32x4 a1 = __builtin_nontemporal_load((const u32x4*)(t1 + (size_t)row * 1024 + ch * 8));
              const u32x4 ga = __builtin_nontemporal_load((const u32x4*)(mg + (size_t)row * 2048 + ch * 8));
              const u32x4 gb = __builtin_nontemporal_load((const u32x4*)(mg + (size_t)row * 2048 + 1024 + ch * 8));
              u32x4 o;
#pragma unroll
              for (int q4 = 0; q4 < 4; ++q4)
                o[q4] = pk2(bflo(ga[q4]) * bflo(a1[q4]) + bflo(gb[q4]) * bflo(a2[q4]),
                            bfhi(ga[q4]) * bfhi(a1[q4]) + bfhi(gb[q4]) * bfhi(a2[q4]));
              *(u32x4*)(tb + (size_t)row * 1024 + ch * 8) = o;
            }
          }
        }
      }
      xcd_barrier(xb, wv, p.ws);

      {
        char* ws = ptr_opaque(p.ws);
        for (int j = 0, mt, nt; xcd_tile256(j, 4, mt, nt); ++j) {
          f32x16 acc[2][4];
#pragma unroll
          for (int a_ = 0; a_ < 2; ++a_)
#pragma unroll
            for (int b_ = 0; b_ < 4; ++b_) zero16(acc[a_][b_]);
          gemm_core256((const bf16_t*)(ws + OFF_WOUT) + (size_t)layer * 1024 * 1024 + (size_t)nt * 256 * 1024,
                       (const bf16_t*)(ws + OFF_TB) + (size_t)mt * 256 * 1024, 1024, acc, lds, wv);
          const int t2 = tid_opaque(wv), l2 = t2 & 63, w2 = t2 >> 6, r = l2 & 31, h = l2 >> 5, wn = w2 & 3, wm = w2 >> 2;
          char* stage = lds + w2 * 18432;
          stage_acc_bf16(acc, stage, r, h);
          const float* modl = (const float*)(ptr_opaque(p.ws) + OFF_MOD) + (size_t)layer * 10 * 3072;
          const int m0 = mt * 256 + wm * 128;
          const int n0 = nt * 256 + wn * 64;
          const float* gt = modl + (seq0 + (m0 >> lgS)) * 3072 + 2048 + n0;
          const int rr = l2 >> 3, ch = l2 & 7;
          const float4 g0 = *(const float4*)(gt + ch * 8), g1 = *(const float4*)(gt + ch * 8 + 4);
#pragma unroll 4
          for (int i = 0; i < 16; ++i) {
            const int row = rr + 8 * i;
            const u32x4 y = *(const u32x4*)(stage + row * 144 + ch * 16);
            const float* xp = xin + (size_t)(m0 + row) * 1024 + n0 + ch * 8;
            const f32x4v xa = __builtin_nontemporal_load((const f32x4v*)xp), xb4 = __builtin_nontemporal_load((const f32x4v*)(xp + 4));
            const float4 x0 = make_float4(xa[0], xa[1], xa[2], xa[3]), x1 = make_float4(xb4[0], xb4[1], xb4[2], xb4[3]);
            float4 o0, o1;
            o0.x = x0.x + g0.x * bflo(y[0]); o0.y = x0.y + g0.y * bfhi(y[0]);
            o0.z = x0.z + g0.z * bflo(y[1]); o0.w = x0.w + g0.w * bfhi(y[1]);
            o1.x = x1.x + g1.x * bflo(y[2]); o1.y = x1.y + g1.y * bfhi(y[2]);
            o1.z = x1.z + g1.z * bflo(y[3]); o1.w = x1.w + g1.w * bfhi(y[3]);
            float* op = xout + (size_t)(m0 + row) * 1024 + n0 + ch * 8;
            __builtin_nontemporal_store((f32x4v){o0.x, o0.y, o0.z, o0.w}, (f32x4v*)op);
            __builtin_nontemporal_store((f32x4v){o1.x, o1.y, o1.z, o1.w}, (f32x4v*)(op + 4));
          }
        }
      }
      {
        const int nl = rd < 3 ? layer : layer + 1, nr = rd < 3 ? rd + 1 : 0;
        if (nl < 2) h_phase(p, nl, nr, wv);
      }
      xcd_barrier(xb, wv, p.ws);
    }
  }

  const int t = tid_opaque(wv), lane = t & 63, w = t >> 6;
  float4 gf[4];
#pragma unroll
  for (int j = 0; j < 4; ++j) gf[j] = *(const float4*)(p.g_final + (lane + 64 * j) * 4);
  for (int row0 = (blockIdx.x * 8 + w) * 4; row0 < 4 * TR; row0 += gridDim.x * 32) {
    float4 v[4][4];
    float ss[4] = {0.f, 0.f, 0.f, 0.f};
#pragma unroll
    for (int u = 0; u < 4; ++u) {
      const float4* xr = (const float4*)(p.out + (size_t)(row0 + u) * 1024);
#pragma unroll
      for (int j = 0; j < 4; ++j) {
        { const f32x4v q_ = __builtin_nontemporal_load((const f32x4v*)(xr + lane + 64 * j)); v[u][j] = make_float4(q_[0], q_[1], q_[2], q_[3]); }
        ss[u] += v[u][j].x * v[u][j].x + v[u][j].y * v[u][j].y + v[u][j].z * v[u][j].z + v[u][j].w * v[u][j].w;
      }
    }
#pragma unroll
    for (int u = 0; u < 4; ++u) {
      const float rs = rsqrtf(wave_sum(ss[u], lane) * (1.f / 1024.f) + EPSN);
      float4* xr = (float4*)(p.out + (size_t)(row0 + u) * 1024);
#pragma unroll
      for (int j = 0; j < 4; ++j) {
        float4 o;
        o.x = v[u][j].x * rs * gf[j].x; o.y = v[u][j].y * rs * gf[j].y; o.z = v[u][j].z * rs * gf[j].z; o.w = v[u][j].w * rs * gf[j].w;
        __builtin_nontemporal_store((f32x4v){o.x, o.y, o.z, o.w}, (f32x4v*)(xr + lane + 64 * j));
      }
    }
  }
}

extern "C" void kernel_launch(void* const* d_in, const int* in_sizes, int n_in, void* d_out, int out_size, void* d_ws,
                              size_t ws_size, hipStream_t stream) {
  static int grid_blocks = 0;
  if (!grid_blocks) {
    hipFuncSetAttribute((const void*)mega_kernel, hipFuncAttributeMaxDynamicSharedMemorySize, LDS_BYTES);
    int dev = 0, cus = 0, per_cu = 0;
    hipGetDevice(&dev);
    hipDeviceGetAttribute(&cus, hipDeviceAttributeMultiprocessorCount, dev);
    hipOccupancyMaxActiveBlocksPerMultiprocessor(&per_cu, mega_kernel, NTHR, LDS_BYTES);
    if (per_cu > 1) per_cu = 1;
    grid_blocks = cus * per_cu;
  }
  if (ws_size < WS_END) fprintf(stderr, "workspace too small: %zu < %zu\n", ws_size, (size_t)WS_END);
  Params p{};
  p.x_prompt = (const float*)d_in[0];
  p.x_sample = (const float*)d_in[1];
  p.c_prompt = (const float*)d_in[2];
  p.c_sample = (const float*)d_in[3];
  p.w_ada = (const float*)d_in[4];
  p.b_ada = (const float*)d_in[5];
  p.g_norm = (const float*)d_in[6];
  p.w_in = (const float*)d_in[7];
  p.b_gate = (const float*)d_in[8];
  p.g_cq = (const float*)d_in[9];
  p.w_uq = (const float*)d_in[10];
  p.g_ckv = (const float*)d_in[11];
  p.w_ukv = (const float*)d_in[12];
  p.w_pa = (const float*)d_in[13];
  p.w_pb = (const float*)d_in[14];
  p.w_out = (const float*)d_in[15];
  p.g_final = (const float*)d_in[16];
  p.out = (float*)d_out;
  p.ws = (char*)d_ws;
  hipMemsetAsync((char*)d_ws + OFF_BAR, 0, 16384, stream);
  void* args[] = {&p};
  hipError_t e = hipLaunchCooperativeKernel((const void*)mega_kernel, dim3(grid_blocks), dim3(NTHR), args, LDS_BYTES, stream);
  if (e != hipSuccess) fprintf(stderr, "cooperative launch failed: %s (grid %d)\n", hipGetErrorString(e), grid_blocks);
}
```

```cpp
#include <hip/hip_runtime.h>
#include <hip/hip_cooperative_groups.h>
#include <cstdio>
namespace cg = cooperative_groups;

typedef unsigned short bf16_t;
typedef __attribute__((ext_vector_type(8))) short bf16x8;
typedef __attribute__((ext_vector_type(4))) short s16x4;
typedef __attribute__((ext_vector_type(2))) float f32x2;
typedef __attribute__((ext_vector_type(16))) float f32x16;
typedef __attribute__((ext_vector_type(2))) __bf16 bf2_t;
typedef __attribute__((ext_vector_type(4))) unsigned u32x4;
typedef __attribute__((ext_vector_type(2))) unsigned u32x2;
typedef __attribute__((ext_vector_type(4))) float f32x4v;
typedef __attribute__((address_space(3))) s16x4 lds_s16x4;

#define DI __device__ __forceinline__
#define MFMA(a, b, c) __builtin_amdgcn_mfma_f32_32x32x16_bf16((a), (b), (c), 0, 0, 0)

constexpr int TR = 16384;
constexpr int NPAD = 8448;
constexpr float EPSN = 1e-6f;
constexpr float LOG2E = 1.4426950408889634f;

constexpr size_t OFF_WIN = 0;
constexpr size_t OFF_WUQ = OFF_WIN + (size_t)2 * NPAD * 1024 * 2;
constexpr size_t OFF_WUKV = OFF_WUQ + (size_t)2 * 768 * 384 * 2;
constexpr size_t OFF_WPA = OFF_WUKV + (size_t)2 * 1024 * 256 * 2;
constexpr size_t OFF_WPB = OFF_WPA + (size_t)2 * 1024 * 512 * 2;
constexpr size_t OFF_WOUT = OFF_WPB + (size_t)2 * 1024 * 512 * 2;
constexpr size_t OFF_ROPE64 = OFF_WOUT + (size_t)2 * 1024 * 1024 * 2;
constexpr size_t OFF_ROPE32 = OFF_ROPE64 + (size_t)16384 * 32 * 8;
constexpr size_t OFF_MOD = OFF_ROPE32 + (size_t)16384 * 16 * 8;
constexpr size_t OFF_ACT = OFF_MOD + (size_t)2 * 10 * 3072 * 4;
constexpr size_t OFF_H = OFF_ACT;
constexpr size_t OFF_CQ = OFF_H + (size_t)TR * 1024 * 2;
constexpr size_t OFF_CKV = OFF_CQ + (size_t)TR * 384 * 2;
constexpr size_t OFF_OG = OFF_H;
constexpr size_t OFF_KPE = OFF_CKV + (size_t)TR * 256 * 2;
constexpr size_t OFF_ZM = OFF_KPE + (size_t)TR * 32 * 2;
constexpr size_t OFF_DIL = OFF_ZM + (size_t)TR * 512 * 2;
constexpr size_t OFF_TB = OFF_DIL;
constexpr size_t OFF_OD = OFF_DIL + (size_t)TR * 1024 * 2;
constexpr size_t OFF_T1 = OFF_DIL + (size_t)TR * 1536 * 2;
constexpr size_t OFF_ZD = OFF_DIL + (size_t)TR * 4608 * 2;
constexpr size_t OFF_MG = OFF_ZD + (size_t)TR * 512 * 2;
constexpr size_t OFF_QM = OFF_MG + (size_t)TR * 2048 * 2;
constexpr size_t OFF_KN = OFF_QM + (size_t)TR * 768 * 2;
constexpr size_t OFF_VM = OFF_KN + (size_t)TR * 512 * 2;
constexpr size_t OFF_OM = OFF_VM + (size_t)TR * 512 * 2;
constexpr size_t OFF_LSE = OFF_OM + (size_t)TR * 512 * 2;
constexpr size_t OFF_BAR = OFF_LSE + (size_t)3 * TR * 8 * 4;
constexpr size_t WS_END = OFF_BAR + 16384;

constexpr int NTHR = 512;
constexpr int LDS_BYTES = 147456 + 1024;

struct Params {
  const float *x_prompt, *x_sample, *c_prompt, *c_sample, *w_ada, *b_ada, *g_norm, *w_in, *b_gate, *g_cq, *w_uq,
      *g_ckv, *w_ukv, *w_pa, *w_pb, *w_out, *g_final;
  float* out;
  char* ws;
};

DI unsigned pk2(float a, float b) {
  f32x2 v = {a, b};
  bf2_t r = __builtin_convertvector(v, bf2_t);
  return __builtin_bit_cast(unsigned, r);
}
DI float bflo(unsigned u) { return __uint_as_float(u << 16); }
DI float bfhi(unsigned u) { return __uint_as_float(u & 0xffff0000u); }
DI int crow(int i, int h) { return (i & 3) + 8 * (i >> 2) + 4 * h; }
DI float silu_f(float x) { return x * __builtin_amdgcn_rcpf(1.f + __expf(-x)); }
DI float sigm_f(float x) { return __builtin_amdgcn_rcpf(1.f + __expf(-x)); }
DI float ex2(float x) { return __builtin_amdgcn_exp2f(x); }

template <int S_>
DI bf16x8 pack_step(const f32x16& x) {
  u32x4 p = {pk2(x[8 * S_], x[8 * S_ + 1]), pk2(x[8 * S_ + 2], x[8 * S_ + 3]), pk2(x[8 * S_ + 4], x[8 * S_ + 5]),
             pk2(x[8 * S_ + 6], x[8 * S_ + 7])};
  return __builtin_bit_cast(bf16x8, p);
}
DI void zero16(f32x16& a) {
#pragma unroll
  for (int i = 0; i < 16; ++i) a[i] = 0.f;
}
DI void store4(bf16_t* dst, float a, float b, float c, float d) {
  u32x2 v = {pk2(a, b), pk2(c, d)};
  *(u32x2*)dst = v;
}
DI bf16x8 tr_frag(const char* p0, const char* p1) {
  s16x4 lo = __builtin_amdgcn_ds_read_tr16_b64_v4i16((lds_s16x4*)p0);
  s16x4 hi = __builtin_amdgcn_ds_read_tr16_b64_v4i16((lds_s16x4*)p1);
  return __builtin_shufflevector(lo, hi, 0, 1, 2, 3, 4, 5, 6, 7);
}

DI int lane_id() { return (int)__builtin_amdgcn_mbcnt_hi(~0u, __builtin_amdgcn_mbcnt_lo(~0u, 0u)); }
DI int tid_opaque(int wv) {
  int t = (wv << 6) | lane_id();
  asm volatile("" : "+v"(t));
  return t;
}
DI char* ptr_opaque(char* p) {
  size_t off = 0;
  asm volatile("" : "+s"(off));
  return p + off;
}

#define XB_TMO 128
#define XB_XCNT(j) (256 + 64 * (j))
#define XB_XSUB(j) (1280 + 64 * (j))
#define XB_XGEN(j) (2304 + 64 * (j))
#define XB_TOP 3328
#define XB_TOPGEN 3392
#define XCD_BAR_WORDS 3456
#define XB_SPIN_CAP (1u << 20)
#define LAS __attribute__((address_space(3)))
DI unsigned xb_ld(unsigned* p) { return __hip_atomic_load(p, __ATOMIC_RELAXED, __HIP_MEMORY_SCOPE_AGENT); }
DI unsigned xb_add(unsigned* p, unsigned v) { return __hip_atomic_fetch_add(p, v, __ATOMIC_RELAXED, __HIP_MEMORY_SCOPE_AGENT); }
DI unsigned xb_xcc_id() { return (unsigned)__builtin_amdgcn_s_getreg((3 << 11) | 20) & 0xFu; }
#define XB_SPIN(cond, bar)                                   \
  do {                                                       \
    unsigned _sp = 0;                                        \
    while (cond) {                                           \
      __builtin_amdgcn_s_sleep(1);                           \
      if ((++_sp & 255u) == 0u) {                            \
        if (xb_ld(&(bar)[XB_TMO])) break;                    \
        if (_sp > XB_SPIN_CAP) {                             \
          atomicAdd(&(bar)[XB_TMO], 1u);                     \
          break;                                             \
        }                                                    \
      }                                                      \
    }                                                        \
  } while (0)
struct XcdBarrier {
  unsigned* bar;
  unsigned x;
  volatile LAS unsigned* st;
};
DI XcdBarrier xcd_barrier_post(unsigned* bar, volatile LAS unsigned* st) {
  XcdBarrier b;
  b.bar = bar;
  b.x = xb_xcc_id();
  b.st = st;
  if (threadIdx.x == 0) (void)xb_add(&bar[XB_XCNT(b.x)], 1u);
  return b;
}
DI void xcd_barrier_complete(unsigned* bar, unsigned x, unsigned& nloc, unsigned& nx) {
  const unsigned G = gridDim.x * gridDim.y * gridDim.z;
  unsigned sum, cnt, mine, sp = 0u;
  for (;;) {
    sum = 0u; cnt = 0u; mine = 0u;
#pragma unroll
    for (unsigned j = 0; j < 16; ++j) {
      const unsigned c = xb_ld(&bar[XB_XCNT(j)]);
      sum += c;
      cnt += (c > 0u) ? 1u : 0u;
      mine = (j == x) ? c : mine;
    }
    if (sum == G) break;
    __builtin_amdgcn_s_sleep(1);
    if ((++sp & 255u) == 0u) {
      if (xb_ld(&bar[XB_TMO])) break;
      if (sp > XB_SPIN_CAP) { atomicAdd(&bar[XB_TMO], 1u); break; }
    }
  }
  nloc = mine > 0u ? mine : 1u;
  nx = cnt > 0u ? cnt : 1u;
}
DI void xcd_barrier(const XcdBarrier& b, int wv, char* wsbase) {
  asm volatile("s_waitcnt vmcnt(0)" ::: "memory");
  __syncthreads();
  if (wv == 0 && lane_id() == 0) {
    unsigned* bar = (unsigned*)(ptr_opaque(wsbase) + OFF_BAR);
    const unsigned bx = xb_xcc_id();
    __builtin_amdgcn_s_waitcnt(0);
    unsigned nloc = b.st[0], nx = b.st[1];
    if (nloc == 0u) {
      xcd_barrier_complete(bar, bx, nloc, nx);
      b.st[0] = nloc;
      b.st[1] = nx;
    }
    const unsigned old = xb_add(&bar[XB_XSUB(bx)], 1u);
    const unsigned gen = old / nloc;
    if (old + 1u == (gen + 1u) * nloc) {
      __builtin_amdgcn_fence(__ATOMIC_RELEASE, "agent");
      asm volatile("s_waitcnt vmcnt(0)" ::: "memory");
      const unsigned og = xb_add(&bar[XB_TOP], 1u);
      const unsigned tg = og / nx;
      if (og + 1u == (tg + 1u) * nx) xb_add(&bar[XB_TOPGEN], 1u);
      else XB_SPIN(xb_ld(&bar[XB_TOPGEN]) == tg, bar);
      __builtin_amdgcn_fence(__ATOMIC_ACQUIRE, "agent");
      xb_add(&bar[XB_XGEN(bx)], 1u);
      asm volatile("s_waitcnt vmcnt(0)" ::: "memory");
    } else {
      XB_SPIN(xb_ld(&bar[XB_XGEN(bx)]) == gen, bar);
      __builtin_amdgcn_fence(__ATOMIC_ACQUIRE, "agent");
      asm volatile("s_waitcnt vmcnt(0)" ::: "memory");
    }
  }
  __syncthreads();
}

DI void vxcd(int& x, int& q, int& nq, int& mper) {
  const bool eight = (gridDim.x & 7) == 0;
  x = eight ? (int)(blockIdx.x & 7) : 0;
  q = eight ? (int)(blockIdx.x >> 3) : (int)blockIdx.x;
  nq = eight ? (int)(gridDim.x >> 3) : (int)gridDim.x;
  mper = eight ? 8 : 64;
}
DI bool xcd_tile256(int j, int NT, int& mt, int& nt) {
  int x, q, nq, mper;
  vxcd(x, q, nq, mper);
  const int e = q + j * nq;
  if (e >= mper * NT) return false;
  nt = e / mper;
  mt = x * mper + e % mper;
  return true;
}

DI bool xcd_tile256_p1(int j, int& mt, int& nt) {
  int x, q, nq, mper;
  vxcd(x, q, nq, mper);
  const int half = mper >> 1;
  const int e = q + j * nq;
  if (e >= mper * 32) return false;
  const int pass = e / (half * 32), rem = e % (half * 32);
  nt = rem / half;
  mt = x * mper + pass * half + rem % half;
  return true;
}

DI void gemm_core256(const bf16_t* Wt, const bf16_t* X, int K, f32x16 (&acc)[2][4], char* lds, int wv) {
  const int t = tid_opaque(wv), lane = t & 63, w = t >> 6, r = lane & 31, h = lane >> 5, wn = w & 3, wm = w >> 2;
  const int lrow = t >> 3, lpart = t & 7;
  const bf16_t* gw = Wt + (size_t)lrow * K + lpart * 8;
  const bf16_t* gx = X + (size_t)lrow * K + lpart * 8;
  char* stw = lds + lrow * 144 + lpart * 16;
  const char* wsp0 = lds + (wn * 64 + r) * 144 + h * 16;
  const char* xsp0 = lds + 36864 + (wm * 128 + r) * 144 + h * 16;
  u32x4 rw[4], rx[4];
  const int nk = K >> 6;
  __syncthreads();
#pragma unroll
  for (int i = 0; i < 4; ++i) {
    rw[i] = *(const u32x4*)(gw + (size_t)(64 * i) * K);
    rx[i] = *(const u32x4*)(gx + (size_t)(64 * i) * K);
  }
#pragma unroll
  for (int i = 0; i < 4; ++i) {
    *(u32x4*)(stw + i * 64 * 144) = rw[i];
    *(u32x4*)(stw + 36864 + i * 64 * 144) = rx[i];
  }
  __syncthreads();
  for (int kt = 0; kt < nk; ++kt) {
    const bool more = kt + 1 < nk;
    if (more) {
#pragma unroll
      for (int i = 0; i < 4; ++i) {
        rw[i] = *(const u32x4*)(gw + (size_t)(64 * i) * K + (kt + 1) * 64);
        rx[i] = *(const u32x4*)(gx + (size_t)(64 * i) * K + (kt + 1) * 64);
      }
    }
    __builtin_amdgcn_sched_barrier(0);
    {
      const char* wsp = wsp0 + (kt & 1) * 73728;
      const char* xsp = xsp0 + (kt & 1) * 73728;
      char* dnx = stw + ((kt + 1) & 1) * 73728;
      bf16x8 fa[2][2], fb[2][2];
#define LFA(BUF, S)                                         \
  fa[BUF][0] = *(const bf16x8*)(wsp + (S) * 32);            \
  fa[BUF][1] = *(const bf16x8*)(wsp + 32 * 144 + (S) * 32);
#define LFB(BUF, S, HB)                                                         \
  fb[BUF][0] = *(const bf16x8*)(xsp + ((HB) * 2) * 32 * 144 + (S) * 32);        \
  fb[BUF][1] = *(const bf16x8*)(xsp + ((HB) * 2 + 1) * 32 * 144 + (S) * 32);
#define MHALF(AB, BB, HB)                                                       \
  acc[0][(HB) * 2] = MFMA(fa[AB][0], fb[BB][0], acc[0][(HB) * 2]);              \
  acc[1][(HB) * 2] = MFMA(fa[AB][1], fb[BB][0], acc[1][(HB) * 2]);              \
  acc[0][(HB) * 2 + 1] = MFMA(fa[AB][0], fb[BB][1], acc[0][(HB) * 2 + 1]);      \
  acc[1][(HB) * 2 + 1] = MFMA(fa[AB][1], fb[BB][1], acc[1][(HB) * 2 + 1]);
#define WST(I)                                                  \
  if (more) {                                                   \
    *(u32x4*)(dnx + (I) * 64 * 144) = rw[I];                    \
    *(u32x4*)(dnx + 36864 + (I) * 64 * 144) = rx[I];            \
  }
#define SB __builtin_amdgcn_sched_barrier(0);
      LFA(0, 0) LFB(0, 0, 0) SB
      LFB(1, 0, 1) SB
      MHALF(0, 0, 0) SB
      LFA(1, 1) LFB(0, 1, 0) SB
      MHALF(0, 1, 1) SB
      LFB(1, 1, 1) SB
      MHALF(1, 0, 0) SB
      LFA(0, 2) LFB(0, 2, 0) SB
      MHALF(1, 1, 1) SB
      LFB(1, 2, 1) SB
      MHALF(0, 0, 0) SB
      LFA(1, 3) LFB(0, 3, 0) WST(0) SB
      MHALF(0, 1, 1) SB
      LFB(1, 3, 1) WST(1) SB
      MHALF(1, 0, 0) SB
      WST(2) SB
      MHALF(1, 1, 1) SB
      WST(3) SB
#undef LFA
#undef LFB
#undef MHALF
#undef WST
#undef SB
    }
    __syncthreads();
  }
}


DI void gemm_core_q(const bf16_t* Wt, const bf16_t* X, int K, f32x16 (&acc)[2], char* lds, int wv) {
  const int t = tid_opaque(wv), lane = t & 63, w = t >> 6, r = lane & 31, h = lane >> 5, wn = w & 3, wm = w >> 2;
  const int lrow = t >> 3, lpart = t & 7;
  const bf16_t* gw = Wt + (size_t)lrow * K + lpart * 8;
  const bf16_t* gx = X + (size_t)lrow * K + lpart * 8;
  char* stw = lds + lrow * 144 + lpart * 16;
  const char* wsp = lds + (wn * 64 + r) * 144 + h * 16;
  const char* xsp = lds + 36864 + (wm * 32 + r) * 144 + h * 16;
  u32x4 rw[4], rx;
  const int nk = K >> 6;
  __syncthreads();
#pragma unroll
  for (int i = 0; i < 4; ++i) rw[i] = *(const u32x4*)(gw + (size_t)(64 * i) * K);
  rx = *(const u32x4*)gx;
  for (int kt = 0; kt < nk; ++kt) {
#pragma unroll
    for (int i = 0; i < 4; ++i) *(u32x4*)(stw + i * 64 * 144) = rw[i];
    *(u32x4*)(stw + 36864) = rx;
    __syncthreads();
    if (kt + 1 < nk) {
#pragma unroll
      for (int i = 0; i < 4; ++i) rw[i] = *(const u32x4*)(gw + (size_t)(64 * i) * K + (kt + 1) * 64);
      rx = *(const u32x4*)(gx + (kt + 1) * 64);
    }
#pragma unroll
    for (int s = 0; s < 4; ++s) {
      const bf16x8 a0 = *(const bf16x8*)(wsp + s * 32);
      const bf16x8 a1 = *(const bf16x8*)(wsp + 32 * 144 + s * 32);
      const bf16x8 b0 = *(const bf16x8*)(xsp + s * 32);
      acc[0] = MFMA(a0, b0, acc[0]);
      acc[1] = MFMA(a1, b0, acc[1]);
    }
    __syncthreads();
  }
}

DI void lds4(char* dst, float a, float b, float c, float d) {
  u32x2 v = {pk2(a, b), pk2(c, d)};
  *(u32x2*)dst = v;
}
DI void p1_epi_block(const Params& p, char* ws, int layer, int S, int nt, int wn, int h, size_t m, f32x16& a0, f32x16& a1,
                     char* srow) {
  const int n64 = nt * 128 + wn * 64;
  const int pos = (int)m & (S - 1);
  if (nt < 5) {
#pragma unroll
    for (int g4 = 0; g4 < 4; ++g4) {
      lds4(srow + (8 * g4 + 4 * h) * 2, a0[4 * g4], a0[4 * g4 + 1], a0[4 * g4 + 2], a0[4 * g4 + 3]);
      lds4(srow + (32 + 8 * g4 + 4 * h) * 2, a1[4 * g4], a1[4 * g4 + 1], a1[4 * g4 + 2], a1[4 * g4 + 3]);
    }
  } else if (nt < 9 || (nt >= 45 && nt < 49)) {
#pragma unroll
    for (int g4 = 0; g4 < 4; ++g4) {
      lds4(srow + (8 * g4 + 4 * h) * 2, silu_f(a0[4 * g4]), silu_f(a0[4 * g4 + 1]), silu_f(a0[4 * g4 + 2]), silu_f(a0[4 * g4 + 3]));
      lds4(srow + (32 + 8 * g4 + 4 * h) * 2, silu_f(a1[4 * g4]), silu_f(a1[4 * g4 + 1]), silu_f(a1[4 * g4 + 2]), silu_f(a1[4 * g4 + 3]));
    }
  } else if (nt < 45) {
    const int c = n64 - 1152;
    const int kind = (c >> 9) % 3;
    if (kind < 2) {
      const float qs = kind == 0 ? 0.125f * LOG2E : 1.f;
      const float2* rt = (const float2*)(ws + OFF_ROPE64) + (size_t)pos * 32;
#pragma unroll
      for (int i = 0; i < 16; ++i) {
        const float2 cs = rt[crow(i, h)];
        const float x1 = a0[i], x2 = a1[i];
        a0[i] = (x1 * cs.x - x2 * cs.y) * qs;
        a1[i] = (x1 * cs.y + x2 * cs.x) * qs;
      }
    }
#pragma unroll
    for (int g4 = 0; g4 < 4; ++g4) {
      lds4(srow + (8 * g4 + 4 * h) * 2, a0[4 * g4], a0[4 * g4 + 1], a0[4 * g4 + 2], a0[4 * g4 + 3]);
      lds4(srow + (32 + 8 * g4 + 4 * h) * 2, a1[4 * g4], a1[4 * g4 + 1], a1[4 * g4 + 2], a1[4 * g4 + 3]);
    }
  } else if (nt < 65) {
    const int c = n64 - 6272;
    const float* bg = p.b_gate + layer * 2048 + c;
#pragma unroll
    for (int g4 = 0; g4 < 4; ++g4) {
      const int o = 8 * g4 + 4 * h;
      const float4 b0 = *(const float4*)(bg + o);
      const float4 b1 = *(const float4*)(bg + 32 + o);
      lds4(srow + (o) * 2, sigm_f(a0[4 * g4] + b0.x), sigm_f(a0[4 * g4 + 1] + b0.y), sigm_f(a0[4 * g4 + 2] + b0.z), sigm_f(a0[4 * g4 + 3] + b0.w));
      lds4(srow + (32 + o) * 2, sigm_f(a1[4 * g4] + b1.x), sigm_f(a1[4 * g4 + 1] + b1.y), sigm_f(a1[4 * g4 + 2] + b1.z), sigm_f(a1[4 * g4 + 3] + b1.w));
    }
  } else if (wn == 0) {
    const float2* rt = (const float2*)(ws + OFF_ROPE32) + (size_t)pos * 16;
#pragma unroll
    for (int i = 0; i < 8; ++i) {
      const float2 cs = rt[crow(i, h)];
      const float x1 = a0[i], x2 = a0[i + 8];
      a0[i] = x1 * cs.x - x2 * cs.y;
      a0[i + 8] = x1 * cs.y + x2 * cs.x;
    }
    bf16_t* dst = (bf16_t*)(ws + OFF_KPE) + m * 32;
#pragma unroll
    for (int g4 = 0; g4 < 4; ++g4) store4(dst + 8 * g4 + 4 * h, a0[4 * g4], a0[4 * g4 + 1], a0[4 * g4 + 2], a0[4 * g4 + 3]);
  }
}


template <int NROWS = 128>
DI void p1_copy_out(char* ws, int nt, int wn, size_t m0, const char* stage, int lane) {
  const int n64 = nt * 128 + wn * 64;
  bf16_t* dbase;
  int ld;
  if (nt < 3) { dbase = (bf16_t*)(ws + OFF_CQ) + n64; ld = 384; }
  else if (nt < 5) { dbase = (bf16_t*)(ws + OFF_CKV) + (n64 - 384); ld = 256; }
  else if (nt < 9) { dbase = (bf16_t*)(ws + OFF_ZM) + (n64 - 640); ld = 512; }
  else if (nt < 45) { dbase = (bf16_t*)(ws + OFF_DIL) + (n64 - 1152); ld = 4608; }
  else if (nt < 49) { dbase = (bf16_t*)(ws + OFF_ZD) + (n64 - 5760); ld = 512; }
  else if (nt < 65) { dbase = (bf16_t*)(ws + OFF_MG) + (n64 - 6272); ld = 2048; }
  else return;
  const int rr = lane >> 3, ch = lane & 7;
#pragma unroll
  for (int i = 0; i < NROWS / 8; ++i) {
    const int row = rr + 8 * i;
    const u32x4 v = *(const u32x4*)(stage + row * 144 + ch * 16);
    __builtin_nontemporal_store(v, (u32x4*)(dbase + (m0 + row) * ld + ch * 8));
  }
}

DI void stage_acc_bf16(f32x16 (&acc)[2][4], char* stage, int r, int h) {
#pragma unroll
  for (int mb = 0; mb < 4; ++mb) {
    char* srow = stage + (mb * 32 + r) * 144;
#pragma unroll
    for (int nb = 0; nb < 2; ++nb)
#pragma unroll
      for (int g4 = 0; g4 < 4; ++g4)
        lds4(srow + (nb * 32 + 8 * g4 + 4 * h) * 2, acc[nb][mb][4 * g4], acc[nb][mb][4 * g4 + 1], acc[nb][mb][4 * g4 + 2],
             acc[nb][mb][4 * g4 + 3]);
  }
}


DI void copy_rows128(const char* stage, bf16_t* dbase, int ld, int lane) {
  const int rr = lane >> 3, ch = lane & 7;
#pragma unroll
  for (int i = 0; i < 16; ++i) {
    const int row = rr + 8 * i;
    __builtin_nontemporal_store(*(const u32x4*)(stage + row * 144 + ch * 16), (u32x4*)(dbase + (size_t)row * ld + ch * 8));
  }
}

DI float lane_xor(float v, int lane, int o) {
  return __int_as_float(__builtin_amdgcn_ds_bpermute((lane ^ o) << 2, __float_as_int(v)));
}
DI float wave_sum(float v, int lane) {
#pragma unroll
  for (int o = 32; o > 0; o >>= 1) v += lane_xor(v, lane, o);
  return v;
}

template <int NCH>
DI float row_rs(const bf16_t* p, float invk) {
  float ss = 0.f;
#pragma unroll 1
  for (int c0 = 0; c0 < NCH; c0 += 4) {
    u32x4 v[4];
#pragma unroll
    for (int c = 0; c < 4; ++c) v[c] = *(const u32x4*)(p + (c0 + c) * 8);
#pragma unroll
    for (int c = 0; c < 4; ++c)
#pragma unroll
      for (int j = 0; j < 4; ++j) {
        const float a = bflo(v[c][j]), b = bfhi(v[c][j]);
        ss += a * a + b * b;
      }
  }
  ss += __shfl_xor(ss, 32);
  return rsqrtf(ss * invk + EPSN);
}

DI void transpose_tile(const float* src, int Nsrc, int K, bf16_t* dst, int k0, int n0, int mode, const float* rowscale,
                       char* lds, int wv) {
  const int tt = tid_opaque(wv), t = tt & 255;
  float* tl = (float*)(lds + (tt >> 8) * 16640);
#pragma unroll
  for (int i = 0; i < 16; ++i) {
    const int kk = (t >> 6) + 4 * i, nn = t & 63;
    const int n = n0 + nn;
    const int sc = mode ? (n < 640 ? n : (n < 8320 ? n + 32 : (n < 8352 ? n - 7680 : -1))) : n;
    float v = sc >= 0 ? src[(size_t)(k0 + kk) * Nsrc + sc] : 0.f;
    if (rowscale) v *= rowscale[k0 + kk];
    tl[nn * 65 + kk] = v;
  }
  __syncthreads();
  {
    const int nn = t >> 2, kp = (t & 3) * 16;
    const float* row = tl + nn * 65 + kp;
    u32x4 o0 = {pk2(row[0], row[1]), pk2(row[2], row[3]), pk2(row[4], row[5]), pk2(row[6], row[7])};
    u32x4 o1 = {pk2(row[8], row[9]), pk2(row[10], row[11]), pk2(row[12], row[13]), pk2(row[14], row[15])};
    bf16_t* d = dst + (size_t)(n0 + nn) * K + k0 + kp;
    *(u32x4*)d = o0;
    *(u32x4*)(d + 8) = o1;
  }
  __syncthreads();
}

DI void mod_item(const Params& p, int it, char* lds, int wv) {
  const int t = tid_opaque(wv);
  const int l = it / 48, chunk = it % 48;
  float* sc = (float*)lds;
  for (int e = t; e < 10240; e += NTHR) {
    const int s = e >> 10, k = e & 1023;
    const float c = s < 8 ? p.c_prompt[s * 1024 + k] : p.c_sample[(s - 8) * 1024 + k];
    sc[e] = c / (1.f + expf(-c));
  }
  __syncthreads();
  const int ks = t >> 6, col = chunk * 64 + (t & 63);
  float a0 = 0, a1 = 0, a2 = 0, a3 = 0, a4 = 0, a5 = 0, a6 = 0, a7 = 0, a8 = 0, a9 = 0;
  const float* wp = p.w_ada + (size_t)l * 1024 * 3072 + col;
#pragma unroll 4
  for (int k = ks * 128; k < ks * 128 + 128; ++k) {
    const float wv_ = wp[(size_t)k * 3072];
    a0 += sc[k] * wv_;
    a1 += sc[1024 + k] * wv_;
    a2 += sc[2048 + k] * wv_;
    a3 += sc[3072 + k] * wv_;
    a4 += sc[4096 + k] * wv_;
    a5 += sc[5120 + k] * wv_;
    a6 += sc[6144 + k] * wv_;
    a7 += sc[7168 + k] * wv_;
    a8 += sc[8192 + k] * wv_;
    a9 += sc[9216 + k] * wv_;
  }
  float* red = (float*)(lds + 40960);
  const int c6 = t & 63;
  red[(ks * 10 + 0) * 64 + c6] = a0;
  red[(ks * 10 + 1) * 64 + c6] = a1;
  red[(ks * 10 + 2) * 64 + c6] = a2;
  red[(ks * 10 + 3) * 64 + c6] = a3;
  red[(ks * 10 + 4) * 64 + c6] = a4;
  red[(ks * 10 + 5) * 64 + c6] = a5;
  red[(ks * 10 + 6) * 64 + c6] = a6;
  red[(ks * 10 + 7) * 64 + c6] = a7;
  red[(ks * 10 + 8) * 64 + c6] = a8;
  red[(ks * 10 + 9) * 64 + c6] = a9;
  __syncthreads();
  float* mod = (float*)(p.ws + OFF_MOD);
  for (int o = t; o < 640; o += NTHR) {
    const int s = o >> 6, c = o & 63;
    float v = 0.f;
#pragma unroll
    for (int q = 0; q < 8; ++q) v += red[(q * 10 + s) * 64 + c];
    const int cc = chunk * 64 + c;
    mod[(l * 10 + s) * 3072 + cc] = v + p.b_ada[l * 3072 + cc];
  }
  __syncthreads();
}

DI void phase0(const Params& p, char* lds, int wv) {
  constexpr int N_MOD = 96;
  constexpr int N_WIN = 2 * 16 * 132, N_WUQ = 2 * 6 * 12, N_WUKV = 2 * 4 * 16, N_WPA = 2 * 8 * 16, N_WOUT = 2 * 16 * 16;
  constexpr int N_TR = N_WIN + N_WUQ + N_WUKV + 2 * N_WPA + N_WOUT;
  constexpr int N_ROPE = (16384 * 32 + 16384 * 16) / NTHR;
  constexpr int TOTAL = N_MOD + N_TR / 2 + N_ROPE;
  for (int it = blockIdx.x; it < TOTAL; it += gridDim.x) {
    if (it < N_MOD) {
      mod_item(p, it, lds, wv);
    } else if (it < N_MOD + N_TR / 2) {
      int j = (it - N_MOD) * 2 + (tid_opaque(wv) >> 8);
      const float* src; bf16_t* dst; const float* rsc = nullptr;
      int Nsrc, K, k0, n0, mode = 0;
      if (j < N_WIN) {
        const int l = j / (16 * 132), rem = j % (16 * 132), kt = rem / 132, nt = rem % 132;
        src = p.w_in + (size_t)l * 1024 * 8352; Nsrc = 8352; K = 1024;
        dst = (bf16_t*)(p.ws + OFF_WIN) + (size_t)l * NPAD * 1024; k0 = kt * 64; n0 = nt * 64; mode = 1;
      } else if ((j -= N_WIN) < N_WUQ) {
        const int l = j / 72, rem = j % 72, kt = rem / 12, nt = rem % 12;
        src = p.w_uq + (size_t)l * 384 * 768; Nsrc = 768; K = 384;
        dst = (bf16_t*)(p.ws + OFF_WUQ) + (size_t)l * 768 * 384; k0 = kt * 64; n0 = nt * 64; rsc = p.g_cq + l * 384;
      } else if ((j -= N_WUQ) < N_WUKV) {
        const int l = j / 64, rem = j % 64, kt = rem / 16, nt = rem % 16;
        src = p.w_ukv + (size_t)l * 256 * 1024; Nsrc = 1024; K = 256;
        dst = (bf16_t*)(p.ws + OFF_WUKV) + (size_t)l * 1024 * 256; k0 = kt * 64; n0 = nt * 64; rsc = p.g_ckv + l * 256;
      } else if ((j -= N_WUKV) < 2 * N_WPA) {
        const int which = j / N_WPA;
        j %= N_WPA;
        const int l = j / 128, rem = j % 128, kt = rem / 16, nt = rem % 16;
        src = (which ? p.w_pb : p.w_pa) + (size_t)l * 512 * 1024; Nsrc = 1024; K = 512;
        dst = (bf16_t*)(p.ws + (which ? OFF_WPB : OFF_WPA)) + (size_t)l * 1024 * 512; k0 = kt * 64; n0 = nt * 64;
      } else {
        j -= 2 * N_WPA;
        const int l = j / 256, rem = j % 256, kt = rem / 16, nt = rem % 16;
        src = p.w_out + (size_t)l * 1024 * 1024; Nsrc = 1024; K = 1024;
        dst = (bf16_t*)(p.ws + OFF_WOUT) + (size_t)l * 1024 * 1024; k0 = kt * 64; n0 = nt * 64;
      }
      transpose_tile(src, Nsrc, K, dst, k0, n0, mode, rsc, lds, wv);
    } else {
      const int idx = (it - N_MOD - N_TR / 2) * NTHR + tid_opaque(wv);
      int pos, f, d;
      float2* dst;
      if (idx < 16384 * 32) {
        pos = idx >> 5; f = idx & 31; d = 64;
        dst = (float2*)(p.ws + OFF_ROPE64) + idx;
      } else {
        const int i2 = idx - 16384 * 32;
        pos = i2 >> 4; f = i2 & 15; d = 32;
        dst = (float2*)(p.ws + OFF_ROPE32) + i2;
      }
      const float inv = exp2f(-(float)(2 * f) / (float)d * 13.287712379549449f);
      const float ang = (float)pos * inv;
      const double a = (double)ang;
      const double kk = rint(a * 0.15915494309189535);
      const float rr = (float)(a - kk * 6.283185307179586);
      *dst = make_float2(__cosf(rr), __sinf(rr));
    }
  }
}

DI void mla_item(const Params& p, int tokbase, int S, int head, int q0, char* lds, int wv) {
  const int t = tid_opaque(wv), lane = t & 63, w = t >> 6, r = lane & 31, h = lane >> 5;
  const bf16_t* qm = (const bf16_t*)(p.ws + OFF_QM);
  const bf16_t* kn = (const bf16_t*)(p.ws + OFF_KN);
  const bf16_t* kpe = (const bf16_t*)(p.ws + OFF_KPE);
  const bf16_t* vm = (const bf16_t*)(p.ws + OFF_VM);
  bf16x8 bq[2][6];
#pragma unroll
  for (int qb = 0; qb < 2; ++qb) {
    const bf16_t* qp = qm + (size_t)(tokbase + q0 + w * 64 + qb * 32 + r) * 768 + head * 96 + h * 8;
#pragma unroll
    for (int s = 0; s < 6; ++s) bq[qb][s] = *(const bf16x8*)(qp + s * 16);
  }
  f32x16 O[2][2];
#pragma unroll
  for (int a = 0; a < 2; ++a)
#pragma unroll
    for (int b = 0; b < 2; ++b) zero16(O[a][b]);
  float mrun[2] = {-1e30f, -1e30f}, lrun[2] = {0.f, 0.f};

  const bool lo = t < 256;
  const int key8 = t >> 3, part8 = t & 7;
  const size_t goff = (size_t)(tokbase + key8) * 512 + head * 64 + part8 * 8;
  const bf16_t* g2 = kpe + (size_t)(tokbase + ((t & 255) >> 2)) * 32 + (t & 3) * 8;
  char* d0 = lds + key8 * 208 + part8 * 16;
  char* d1 = lds + 13312 + key8 * 144 + part8 * 16;
  char* d2 = lds + ((t & 255) >> 2) * 208 + 128 + (t & 3) * 16;
  u32x4 st[3];
  st[0] = *(const u32x4*)(kn + goff); st[1] = *(const u32x4*)(vm + goff);
  if (lo) st[2] = *(const u32x4*)g2;
  *(u32x4*)d0 = st[0]; *(u32x4*)d1 = st[1];
  if (lo) *(u32x4*)d2 = st[2];
  __syncthreads();
  const int i16 = lane & 15, tq = i16 >> 2, tp = i16 & 3, tblk = (lane >> 4) & 1;
  const int voff = 13312 + (4 * h + tq) * 144 + 32 * tblk + 8 * tp;
  const int koff = r * 208 + h * 16;
  const int nt = S >> 6;
  for (int kt = 0; kt < nt; ++kt) {
    const bool more = kt + 1 < nt;
    const char* buf = lds + (kt & 1) * 22528;
    bf16x8 kf[6];
    {
      const char* kp = buf + koff;
#pragma unroll
      for (int s = 0; s < 6; ++s) kf[s] = *(const bf16x8*)(kp + s * 32);
    }
    __builtin_amdgcn_sched_barrier(0);
#pragma unroll
    for (int kb = 0; kb < 2; ++kb) {
      f32x16 sc[2];
      zero16(sc[0]); zero16(sc[1]);
#pragma unroll
      for (int s = 0; s < 6; ++s) {
        sc[0] = MFMA(kf[s], bq[0][s], sc[0]);
        sc[1] = MFMA(kf[s], bq[1][s], sc[1]);
      }
      __builtin_amdgcn_sched_barrier(0);
      bf16x8 vf[2][2];
      {
        const char* vp = buf + voff + kb * 32 * 144;
#pragma unroll
        for (int s = 0; s < 2; ++s)
#pragma unroll
          for (int dvb = 0; dvb < 2; ++dvb)
            vf[s][dvb] = tr_frag(vp + (16 * s) * 144 + dvb * 64, vp + (16 * s + 8) * 144 + dvb * 64);
      }
      if (kb == 0) {
        const char* kp = buf + koff + 32 * 208;
#pragma unroll
        for (int s = 0; s < 6; ++s) kf[s] = *(const bf16x8*)(kp + s * 32);
      }
      __builtin_amdgcn_sched_barrier(0);
      bf16x8 pf[2][2];
#pragma unroll
      for (int qb = 0; qb < 2; ++qb) {
        const f32x2 m2 = {mrun[qb], mrun[qb]};
        f32x2 ls2 = {0.f, 0.f};
        u32x4 pk0, pk1;
#pragma unroll
        for (int i = 0; i < 16; i += 2) {
          f32x2 v = {sc[qb][i], sc[qb][i + 1]};
          v = v - m2;
          v[0] = ex2(v[0]);
          v[1] = ex2(v[1]);
          ls2 = ls2 + v;
          if (i < 8) pk0[i >> 1] = pk2(v[0], v[1]);
          else pk1[(i - 8) >> 1] = pk2(v[0], v[1]);
        }
        float ls = ls2[0] + ls2[1];
        if (__builtin_amdgcn_ballot_w64(!(ls < 2048.f)) != 0) {
          float mx = fmaxf(fmaxf(sc[qb][0], sc[qb][1]), sc[qb][2]);
#pragma unroll
          for (int i = 3; i < 15; i += 2) mx = fmaxf(fmaxf(mx, sc[qb][i]), sc[qb][i + 1]);
          mx = fmaxf(mx, sc[qb][15]);
          const float mxx = fmaxf(mx, lane_xor(mx, lane, 32));
          const float mnew = fmaxf(mrun[qb], mxx);
          const float alpha = ex2(mrun[qb] - mnew);
          mrun[qb] = mnew;
          lrun[qb] *= alpha;
#pragma unroll
          for (int i = 0; i < 16; ++i) {
            O[0][qb][i] *= alpha;
            O[1][qb][i] *= alpha;
          }
          ls = 0.f;
#pragma unroll
          for (int i = 0; i < 16; i += 2) {
            const float e0 = ex2(sc[qb][i] - mnew), e1 = ex2(sc[qb][i + 1] - mnew);
            ls += e0 + e1;
            if (i < 8) pk0[i >> 1] = pk2(e0, e1);
            else pk1[(i - 8) >> 1] = pk2(e0, e1);
          }
        }
        lrun[qb] += ls;
        pf[qb][0] = __builtin_bit_cast(bf16x8, pk0);
        pf[qb][1] = __builtin_bit_cast(bf16x8, pk1);
      }
      __builtin_amdgcn_sched_barrier(0);
#pragma unroll
      for (int s = 0; s < 2; ++s) {
#pragma unroll
        for (int dvb = 0; dvb < 2; ++dvb) {
          O[dvb][0] = MFMA(vf[s][dvb], pf[0][s], O[dvb][0]);
          O[dvb][1] = MFMA(vf[s][dvb], pf[1][s], O[dvb][1]);
        }
      }
      __builtin_amdgcn_sched_barrier(0);
      if (kb == 0 && more) {
        const size_t o5 = goff + (size_t)(kt + 1) * 64 * 512;
        st[0] = *(const u32x4*)(kn + o5); st[1] = *(const u32x4*)(vm + o5);
        if (lo) st[2] = *(const u32x4*)(g2 + (size_t)(kt + 1) * 64 * 32);
        __builtin_amdgcn_sched_barrier(0);
      }
    }
    if (more) {
      const int bo = ((kt + 1) & 1) * 22528;
      *(u32x4*)(d0 + bo) = st[0]; *(u32x4*)(d1 + bo) = st[1];
      if (lo) *(u32x4*)(d2 + bo) = st[2];
    }
    __syncthreads();
  }
  const bf16_t* zm = (const bf16_t*)(p.ws + OFF_ZM);
  bf16_t* om = (bf16_t*)(p.ws + OFF_OM);
#pragma unroll
  for (int qb = 0; qb < 2; ++qb) {
    const float l = lrun[qb] + lane_xor(lrun[qb], lane, 32);
    const float inv = __builtin_amdgcn_rcpf(l);
    const size_t tok = (size_t)(tokbase + q0 + w * 64 + qb * 32 + r);
#pragma unroll
    for (int dvb = 0; dvb < 2; ++dvb)
#pragma unroll
      for (int g4 = 0; g4 < 4; ++g4) {
        const int col = head * 64 + dvb * 32 + 8 * g4 + 4 * h;
        const u32x2 z = *(const u32x2*)(zm + tok * 512 + col);
        store4(om + tok * 512 + col, O[dvb][qb][4 * g4] * inv * bflo(z[0]), O[dvb][qb][4 * g4 + 1] * inv * bfhi(z[0]),
               O[dvb][qb][4 * g4 + 2] * inv * bflo(z[1]), O[dvb][qb][4 * g4 + 3] * inv * bfhi(z[1]));
      }
  }
}

DI void dil_item(const Params& p, int tokbase, int S, int head, int g, int dil, int cls, int np, char* lds, int wv) {
  const int t = tid_opaque(wv), lane = t & 63, w = t >> 6, r = lane & 31, h = lane >> 5;
  const bf16_t* db = (const bf16_t*)(p.ws + OFF_DIL);
  const int L = S / dil;
  const int l0 = np * 256 - 64;
  {
    const int part = t & 7;
#pragma unroll
    for (int pass = 0; pass < 2; ++pass) {
      u32x4 v[6];
#pragma unroll
      for (int i = 0; i < 6; ++i) {
        const int kk = (t >> 3) + 64 * i;
        const int l = l0 + kk;
        const bool ok = (unsigned)l < (unsigned)L;
        const size_t tok = (size_t)(tokbase + (ok ? l : 0) * dil + cls);
        u32x4 x = *(const u32x4*)(db + tok * 4608 + (3 * g + 1 + pass) * 512 + head * 64 + part * 8);
        if (!ok) x = (u32x4){0u, 0u, 0u, 0u};
        v[i] = x;
      }
#pragma unroll
      for (int i = 0; i < 6; ++i) {
        const int kk = (t >> 3) + 64 * i;
        *(u32x4*)(lds + pass * 55296 + kk * 144 + part * 16) = v[i];
      }
    }
  }
  __syncthreads();
  const int lq = np * 256 + w * 32 + r;
  const size_t tokq = (size_t)(tokbase + lq * dil + cls);
  bf16x8 bq[4];
  {
    const bf16_t* qp = db + tokq * 4608 + (3 * g) * 512 + head * 64 + h * 8;
#pragma unroll
    for (int s = 0; s < 4; ++s) bq[s] = *(const bf16x8*)(qp + s * 16);
  }
  f32x16 sc[5];
#pragma unroll
  for (int kb = 0; kb < 5; ++kb) {
    zero16(sc[kb]);
    const char* kp = lds + (w * 32 + kb * 32 + r) * 144 + h * 16;
#pragma unroll
    for (int s = 0; s < 4; ++s) {
      bf16x8 ka = *(const bf16x8*)(kp + s * 32);
      sc[kb] = MFMA(ka, bq[s], sc[kb]);
    }
  }
  float mx = -1e30f;
#pragma unroll
  for (int kb = 0; kb < 5; ++kb)
#pragma unroll
    for (int i = 0; i < 16; ++i) {
      const int c = crow(i, h);
      const int lk = l0 + w * 32 + kb * 32 + c;
      bool ok = (unsigned)lk < (unsigned)L;
      if (kb == 0) ok = ok && (c >= r);
      if (kb == 4) ok = ok && (c <= r);
      const float v = ok ? sc[kb][i] : -1e30f;
      sc[kb][i] = v;
      mx = fmaxf(mx, v);
    }
  mx = fmaxf(mx, lane_xor(mx, lane, 32));
  float ls = 0.f;
#pragma unroll
  for (int kb = 0; kb < 5; ++kb)
#pragma unroll
    for (int i = 0; i < 16; ++i) {
      const float pv = ex2(sc[kb][i] - mx);
      sc[kb][i] = pv;
      ls += pv;
    }
  ls += lane_xor(ls, lane, 32);
  f32x16 O[2];
  zero16(O[0]); zero16(O[1]);
  const int i16 = lane & 15, tq = i16 >> 2, tp = i16 & 3, tblk = (lane >> 4) & 1;
  const char* vbase = lds + 55296 + (w * 32 + 4 * h + tq) * 144 + 32 * tblk + 8 * tp;
#pragma unroll
  for (int kb = 0; kb < 5; ++kb) {
    bf16x8 pf0 = pack_step<0>(sc[kb]);
    bf16x8 pf1 = pack_step<1>(sc[kb]);
#pragma unroll
    for (int dvb = 0; dvb < 2; ++dvb) {
      bf16x8 v0 = tr_frag(vbase + (kb * 32) * 144 + dvb * 64, vbase + (kb * 32 + 8) * 144 + dvb * 64);
      O[dvb] = MFMA(v0, pf0, O[dvb]);
      bf16x8 v1 = tr_frag(vbase + (kb * 32 + 16) * 144 + dvb * 64, vbase + (kb * 32 + 24) * 144 + dvb * 64);
      O[dvb] = MFMA(v1, pf1, O[dvb]);
    }
  }
  const float inv = __builtin_amdgcn_rcpf(ls);
  bf16_t* og = (bf16_t*)(p.ws + OFF_OG) + (size_t)g * TR * 512;
#pragma unroll
  for (int dvb = 0; dvb < 2; ++dvb)
#pragma unroll
    for (int g4 = 0; g4 < 4; ++g4) {
      const int col = head * 64 + dvb * 32 + 8 * g4 + 4 * h;
      store4(og + tokq * 512 + col, O[dvb][4 * g4] * inv, O[dvb][4 * g4 + 1] * inv, O[dvb][4 * g4 + 2] * inv,
             O[dvb][4 * g4 + 3] * inv);
    }
  if (h == 0) {
    float* lse = (float*)(p.ws + OFF_LSE);
    lse[((size_t)g * TR + tokq) * 8 + head] = mx + __log2f(ls);
  }
  __syncthreads();
}


DI void h_phase(const Params& p, int layer, int rd, int wv) {
  const int t = tid_opaque(wv), lane = t & 63, w = t >> 6;
  char* ws = ptr_opaque(p.ws);
  const float* xin = layer == 0 ? (rd < 2 ? p.x_prompt + (size_t)rd * TR * 1024 : p.x_sample + (size_t)(rd - 2) * TR * 1024)
                                : p.out + (size_t)rd * TR * 1024;
  const int lgS = rd < 2 ? 12 : 14;
  const int seq0 = rd < 2 ? rd * 4 : 8 + (rd - 2);
  const float* modl = (const float*)(ws + OFF_MOD) + (size_t)layer * 10 * 3072;
  bf16_t* hb = (bf16_t*)(ws + OFF_H);
  const float* gn = p.g_norm + layer * 1024;
  for (int row0 = (blockIdx.x * 8 + w) * 4; row0 < TR; row0 += gridDim.x * 32) {
    float4 v[4][4];
    float ss[4] = {0.f, 0.f, 0.f, 0.f};
#pragma unroll
    for (int u = 0; u < 4; ++u) {
      const float4* xr = (const float4*)(xin + (size_t)(row0 + u) * 1024);
#pragma unroll
      for (int j = 0; j < 4; ++j) {
        { const f32x4v q_ = __builtin_nontemporal_load((const f32x4v*)(xr + lane + 64 * j)); v[u][j] = make_float4(q_[0], q_[1], q_[2], q_[3]); }
        ss[u] += v[u][j].x * v[u][j].x + v[u][j].y * v[u][j].y + v[u][j].z * v[u][j].z + v[u][j].w * v[u][j].w;
      }
    }
    const float* md = modl + (seq0 + (row0 >> lgS)) * 3072;
#pragma unroll
    for (int u = 0; u < 4; ++u) {
      const float rs = rsqrtf(wave_sum(ss[u], lane) * (1.f / 1024.f) + EPSN);
#pragma unroll
      for (int j = 0; j < 4; ++j) {
        const int n = (lane + 64 * j) * 4;
        const float4 g = *(const float4*)(gn + n);
        const float4 sh = *(const float4*)(md + n);
        const float4 sc = *(const float4*)(md + 1024 + n);
        store4(hb + (size_t)(row0 + u) * 1024 + n, v[u][j].x * rs * g.x * (1.f + sc.x) + sh.x, v[u][j].y * rs * g.y * (1.f + sc.y) + sh.y,
               v[u][j].z * rs * g.z * (1.f + sc.z) + sh.z, v[u][j].w * rs * g.w * (1.f + sc.w) + sh.w);
      }
    }
  }
}

__global__ void __launch_bounds__(512, 2) mega_kernel(Params p) {
  extern __shared__ __attribute__((aligned(16))) char lds[];
  cg::grid_group grid = cg::this_grid();

  const int wv = __builtin_amdgcn_readfirstlane((int)(threadIdx.x >> 6));
  __shared__ uint4 xb_words;
  if (threadIdx.x == 0) xb_words = make_uint4(0u, 0u, 0u, 0u);
  __syncthreads();
  const XcdBarrier xb = xcd_barrier_post((unsigned*)(p.ws + OFF_BAR), (volatile LAS unsigned*)&xb_words);

  phase0(p, lds, wv);
  grid.sync();
  h_phase(p, 0, 0, wv);
  xcd_barrier(xb, wv, p.ws);

  for (int layer = 0; layer < 2; ++layer) {
    for (int rd = 0; rd < 4; ++rd) {
      const float* xin = layer == 0 ? (rd < 2 ? p.x_prompt + (size_t)rd * TR * 1024 : p.x_sample + (size_t)(rd - 2) * TR * 1024)
                                    : p.out + (size_t)rd * TR * 1024;
      float* xout = p.out + (size_t)rd * TR * 1024;
      const int S = rd < 2 ? 4096 : 16384;
      const int lgS = rd < 2 ? 12 : 14;
      const int seq0 = rd < 2 ? rd * 4 : 8 + (rd - 2);

      {
        char* ws = ptr_opaque(p.ws);
        const bf16_t* wt = (const bf16_t*)(ws + OFF_WIN) + (size_t)layer * NPAD * 1024;
        const bf16_t* hb = (const bf16_t*)(ws + OFF_H);
        for (int j = 0, mt, nt; xcd_tile256_p1(j, mt, nt); ++j) {
          f32x16 acc[2][4];
#pragma unroll
          for (int a_ = 0; a_ < 2; ++a_)
#pragma unroll
            for (int b_ = 0; b_ < 4; ++b_) zero16(acc[a_][b_]);
          gemm_core256(wt + (size_t)nt * 256 * 1024, hb + (size_t)mt * 256 * 1024, 1024, acc, lds, wv);
          {
            const int t2 = tid_opaque(wv), l2 = t2 & 63, w2 = t2 >> 6, r2 = l2 & 31, h2 = l2 >> 5, wn2 = w2 & 3, wm2 = w2 >> 2;
            char* ws2 = ptr_opaque(p.ws);
            char* stage = lds + w2 * 18432;
#pragma unroll
            for (int mb = 0; mb < 4; ++mb)
              p1_epi_block(p, ws2, layer, S, nt * 2 + (wn2 >> 1), wn2 & 1, h2, (size_t)(mt * 256 + wm2 * 128 + mb * 32 + r2), acc[0][mb],
                           acc[1][mb], stage + (mb * 32 + r2) * 144);
            p1_copy_out(ws2, nt * 2 + (wn2 >> 1), wn2 & 1, (size_t)(mt * 256 + wm2 * 128), stage, l2);
          }
        }
        {
          int x, q, nq, mper;
          vxcd(x, q, nq, mper);
          for (int e = q; e < mper * 4; e += nq) {
            const int nt = 32;
            const int m0t = (x * mper + (e >> 2)) * 256 + (e & 3) * 64;
            f32x16 acc[2];
            zero16(acc[0]); zero16(acc[1]);
            gemm_core_q(wt + (size_t)nt * 256 * 1024, hb + (size_t)m0t * 1024, 1024, acc, lds, wv);
            const int t2 = tid_opaque(wv), l2 = t2 & 63, w2 = t2 >> 6, r2 = l2 & 31, h2 = l2 >> 5, wn2 = w2 & 3, wm2 = w2 >> 2;
            char* ws2 = ptr_opaque(p.ws);
            char* stage = lds + w2 * 18432;
            p1_epi_block(p, ws2, layer, S, nt * 2 + (wn2 >> 1), wn2 & 1, h2, (size_t)(m0t + wm2 * 32 + r2), acc[0], acc[1],
                         stage + r2 * 144);
            p1_copy_out<32>(ws2, nt * 2 + (wn2 >> 1), wn2 & 1, (size_t)(m0t + wm2 * 32), stage, l2);
          }
        }
      }
      xcd_barrier(xb, wv, p.ws);

      {
        char* ws = ptr_opaque(p.ws);
        for (int j = 0, mt, nt; xcd_tile256(j, 3, mt, nt); ++j) {
          f32x16 acc[2][4];
#pragma unroll
          for (int a_ = 0; a_ < 2; ++a_)
#pragma unroll
            for (int b_ = 0; b_ < 4; ++b_) zero16(acc[a_][b_]);
          {
            const bf16_t* cq = (const bf16_t*)(ws + OFF_CQ);
          {
            __syncthreads();
            const int t0 = tid_opaque(wv), row = t0 >> 1, half = t0 & 1;
            const bf16_t* rp = cq + (size_t)(mt * 256 + row) * 384 + half * (384 / 2);
            float ss = 0.f;
#pragma unroll 1
            for (int c0 = 0; c0 < 384 / 16; c0 += 8) {
              u32x4 v[8];
#pragma unroll
              for (int c = 0; c < 8; ++c) v[c] = *(const u32x4*)(rp + (c0 + c) * 8);
#pragma unroll
              for (int c = 0; c < 8; ++c)
#pragma unroll
                for (int jj = 0; jj < 4; ++jj) {
                  const float a = bflo(v[c][jj]), b = bfhi(v[c][jj]);
                  ss += a * a + b * b;
                }
            }
            ss += lane_xor(ss, t0 & 63, 1);
            if (!half) ((float*)(lds + 147456))[row] = rsqrtf(ss * (1.f / 384) + EPSN);
          }
            gemm_core256((const bf16_t*)(ws + OFF_WUQ) + (size_t)layer * 768 * 384 + (size_t)nt * 256 * 384,
                         cq + (size_t)mt * 256 * 384, 384, acc, lds, wv);
            const int t2 = tid_opaque(wv), l2 = t2 & 63, w2 = t2 >> 6, r = l2 & 31, h = l2 >> 5, wn = w2 & 3, wm = w2 >> 2;
            const float2* rope32 = (const float2*)(ptr_opaque(p.ws) + OFF_ROPE32);
            const float qs = 0.10206207261596575f * LOG2E;
#pragma unroll
            for (int mb = 0; mb < 4; ++mb) {
              __builtin_amdgcn_sched_barrier(0);
              const size_t m = (size_t)(mt * 256 + wm * 128 + mb * 32 + r);
              const int pos = (int)m & (S - 1);
              const float rs = ((const float*)(lds + 147456))[wm * 128 + mb * 32 + r] * qs;
              const float2* rt = rope32 + (size_t)pos * 16;
#pragma unroll
              for (int nb = 0; nb < 2; ++nb) {
                const int c0 = nt * 256 + wn * 64 + nb * 32;
                if (c0 % 96 == 64) {
#pragma unroll
                  for (int i = 0; i < 8; ++i) {
                    const float2 cs = rt[crow(i, h)];
                    const float x1 = acc[nb][mb][i], x2 = acc[nb][mb][i + 8];
                    acc[nb][mb][i] = x1 * cs.x - x2 * cs.y;
                    acc[nb][mb][i + 8] = x1 * cs.y + x2 * cs.x;
                  }
                }
                char* srow = lds + w2 * 18432 + (mb * 32 + r) * 144 + nb * 64;
#pragma unroll
                for (int g4 = 0; g4 < 4; ++g4)
                  lds4(srow + (8 * g4 + 4 * h) * 2, acc[nb][mb][4 * g4] * rs, acc[nb][mb][4 * g4 + 1] * rs, acc[nb][mb][4 * g4 + 2] * rs,
                       acc[nb][mb][4 * g4 + 3] * rs);
              }
            }
            copy_rows128(lds + w2 * 18432, (bf16_t*)(ws + OFF_QM) + (size_t)(mt * 256 + wm * 128) * 768 + nt * 256 + wn * 64, 768, l2);
          }
        }
        for (int j = 0, mt, nt; xcd_tile256(j, 4, mt, nt); ++j) {
          f32x16 acc[2][4];
#pragma unroll
          for (int a_ = 0; a_ < 2; ++a_)
#pragma unroll
            for (int b_ = 0; b_ < 4; ++b_) zero16(acc[a_][b_]);
          {
            const bf16_t* ckv = (const bf16_t*)(ws + OFF_CKV);
          {
            __syncthreads();
            const int t0 = tid_opaque(wv), row = t0 >> 1, half = t0 & 1;
            const bf16_t* rp = ckv + (size_t)(mt * 256 + row) * 256 + half * (256 / 2);
            float ss = 0.f;
#pragma unroll 1
            for (int c0 = 0; c0 < 256 / 16; c0 += 8) {
              u32x4 v[8];
#pragma unroll
              for (int c = 0; c < 8; ++c) v[c] = *(const u32x4*)(rp + (c0 + c) * 8);
#pragma unroll
              for (int c = 0; c < 8; ++c)
#pragma unroll
                for (int jj = 0; jj < 4; ++jj) {
                  const float a = bflo(v[c][jj]), b = bfhi(v[c][jj]);
                  ss += a * a + b * b;
                }
            }
            ss += lane_xor(ss, t0 & 63, 1);
            if (!half) ((float*)(lds + 147456))[row] = rsqrtf(ss * (1.f / 256) + EPSN);
          }
            gemm_core256((const bf16_t*)(ws + OFF_WUKV) + (size_t)layer * 1024 * 256 + (size_t)nt * 256 * 256,
                         ckv + (size_t)mt * 256 * 256, 256, acc, lds, wv);
            const int t2 = tid_opaque(wv), l2 = t2 & 63, w2 = t2 >> 6, r = l2 & 31, h = l2 >> 5, wn = w2 & 3, wm = w2 >> 2;
            const int c64 = nt * 256 + wn * 64;
            const int hd = c64 >> 7, isv = (c64 >> 6) & 1;
#pragma unroll
            for (int mb = 0; mb < 4; ++mb) {
              __builtin_amdgcn_sched_barrier(0);
              const size_t m = (size_t)(mt * 256 + wm * 128 + mb * 32 + r);
              const float rs = ((const float*)(lds + 147456))[wm * 128 + mb * 32 + r];
              char* srow = lds + w2 * 18432 + (mb * 32 + r) * 144;
#pragma unroll
              for (int nb = 0; nb < 2; ++nb)
#pragma unroll
                for (int g4 = 0; g4 < 4; ++g4)
                  lds4(srow + (nb * 32 + 8 * g4 + 4 * h) * 2, acc[nb][mb][4 * g4] * rs, acc[nb][mb][4 * g4 + 1] * rs,
                       acc[nb][mb][4 * g4 + 2] * rs, acc[nb][mb][4 * g4 + 3] * rs);
            }
            copy_rows128(lds + w2 * 18432, (bf16_t*)(ws + (isv ? OFF_VM : OFF_KN)) + (size_t)(mt * 256 + wm * 128) * 512 + hd * 64, 512, l2);
          }
        }
      }
      xcd_barrier(xb, wv, p.ws);

      {
        const int nseq = TR >> lgS;
        const int nqb = S >> 9;
        const int per_x = nseq;
        for (int it = blockIdx.x; it < 256 + 1536; it += gridDim.x) {
          if (it < 256) {
            const int x = it & 7, j = it >> 3;
            const int pair = x * per_x + j / nqb, qb = j % nqb;
            const int sl = pair >> 3, head = pair & 7;
            mla_item(p, sl << lgS, S, head, qb * 512, lds, wv);
          } else {
            const int j = it - 256;
            const int g = j >> 9, jj = j & 511;
            const int head = jj & 7, blk = jj >> 3;
            const int bps = S >> 8;
            const int sl = blk / bps, b2 = blk % bps;
            const int dil = g == 0 ? 1 : (g == 1 ? 4 : 16);
            const int bpc = bps / dil;
            const int cls = b2 / bpc, np = b2 % bpc;
            dil_item(p, sl << lgS, S, head, g, dil, cls, np, lds, wv);
          }
        }
      }
      xcd_barrier(xb, wv, p.ws);

      {
        const int t = tid_opaque(wv), lane = t & 63, w = t >> 6, r = lane & 31, h = lane >> 5, wn = w & 1, wm = w >> 1;
        char* ws = ptr_opaque(p.ws);
        const float* modl = (const float*)(ws + OFF_MOD) + (size_t)layer * 10 * 3072;
        (void)t; (void)lane; (void)w; (void)r; (void)h; (void)wn; (void)wm; (void)modl;
        const float* lse = (const float*)(ws + OFF_LSE);
        const bf16_t* og = (const bf16_t*)(ws + OFF_OG);
        const bf16_t* zd = (const bf16_t*)(ws + OFF_ZD);
        bf16_t* od = (bf16_t*)(ws + OFF_OD);
        for (int idx0 = blockIdx.x * NTHR + t; idx0 < TR * 64; idx0 += gridDim.x * NTHR * 4) {
#pragma unroll
          for (int u = 0; u < 4; ++u) {
            const int idx = idx0 + u * gridDim.x * NTHR;
            if (idx >= TR * 64) break;
          const size_t tok = (size_t)(idx >> 6);
          const int hp = idx & 63, head = hp >> 3;
          const float l0 = lse[tok * 8 + head], l1 = lse[((size_t)TR + tok) * 8 + head], l2 = lse[((size_t)2 * TR + tok) * 8 + head];
          const float mx = fmaxf(l0, fmaxf(l1, l2));
          float w0 = ex2(l0 - mx), w1 = ex2(l1 - mx), w2 = ex2(l2 - mx);
          const float inv = __builtin_amdgcn_rcpf(w0 + w1 + w2);
          w0 *= inv; w1 *= inv; w2 *= inv;
          const size_t e = tok * 512 + hp * 8;
          const u32x4 a = __builtin_nontemporal_load((const u32x4*)(og + e)),
                      b = __builtin_nontemporal_load((const u32x4*)(og + (size_t)TR * 512 + e)),
                      c = __builtin_nontemporal_load((const u32x4*)(og + (size_t)2 * TR * 512 + e)),
                      z = __builtin_nontemporal_load((const u32x4*)(zd + e));
          u32x4 o;
#pragma unroll
          for (int j = 0; j < 4; ++j) {
            const float lo = (w0 * bflo(a[j]) + w1 * bflo(b[j]) + w2 * bflo(c[j])) * bflo(z[j]);
            const float hi = (w0 * bfhi(a[j]) + w1 * bfhi(b[j]) + w2 * bfhi(c[j])) * bfhi(z[j]);
            o[j] = pk2(lo, hi);
          }
          *(u32x4*)(od + e) = o;
          }
        }
      }
      xcd_barrier(xb, wv, p.ws);

      {
        char* ws = ptr_opaque(p.ws);
        for (int j = 0, mt, nt; xcd_tile256(j, 4, mt, nt); ++j) {
          f32x16 acc[2][4];
#pragma unroll
          for (int a_ = 0; a_ < 2; ++a_)
#pragma unroll
            for (int b_ = 0; b_ < 4; ++b_) zero16(acc[a_][b_]);
          gemm_core256((const bf16_t*)(ws + OFF_WPA) + (size_t)layer * 1024 * 512 + (size_t)nt * 256 * 512,
                       (const bf16_t*)(ws + OFF_OM) + (size_t)mt * 256 * 512, 512, acc, lds, wv);
          {
            const int t2 = tid_opaque(wv), l2 = t2 & 63, w2 = t2 >> 6, r = l2 & 31, h = l2 >> 5, wn = w2 & 3, wm = w2 >> 2;
            char* stage = lds + w2 * 18432;
            stage_acc_bf16(acc, stage, r, h);
            bf16_t* t1 = (bf16_t*)(ptr_opaque(p.ws) + OFF_T1) + (size_t)(mt * 256 + wm * 128) * 1024 + nt * 256 + wn * 64;
            const int rr = l2 >> 3, ch = l2 & 7;
#pragma unroll
            for (int i = 0; i < 16; ++i) {
              const int row = rr + 8 * i;
              *(u32x4*)(t1 + (size_t)row * 1024 + ch * 8) = *(const u32x4*)(stage + row * 144 + ch * 16);
            }
          }
#pragma unroll
          for (int a_ = 0; a_ < 2; ++a_)
#pragma unroll
            for (int b_ = 0; b_ < 4; ++b_) zero16(acc[a_][b_]);
          gemm_core256((const bf16_t*)(ws + OFF_WPB) + (size_t)layer * 1024 * 512 + (size_t)nt * 256 * 512,
                       (const bf16_t*)(ws + OFF_OD) + (size_t)mt * 256 * 512, 512, acc, lds, wv);
          {
            const int t2 = tid_opaque(wv), l2 = t2 & 63, w2 = t2 >> 6, r = l2 & 31, h = l2 >> 5, wn = w2 & 3, wm = w2 >> 2;
            char* stage = lds + w2 * 18432;
            stage_acc_bf16(acc, stage, r, h);
            char* ws2 = ptr_opaque(p.ws);
            const size_t m0 = (size_t)(mt * 256 + wm * 128);
            const int n0 = nt * 256 + wn * 64;
            const bf16_t* t1 = (const bf16_t*)(ws2 + OFF_T1) + m0 * 1024 + n0;
            const bf16_t* mg = (const bf16_t*)(ws2 + OFF_MG) + m0 * 2048 + n0;
            bf16_t* tb = (bf16_t*)(ws2 + OFF_TB) + m0 * 1024 + n0;
            const int rr = l2 >> 3, ch = l2 & 7;
#pragma unroll 4
            for (int i = 0; i < 16; ++i) {
              const int row = rr + 8 * i;
              const u32x4 a2 = *(const u32x4*)(stage + row * 144 + ch * 16);
              const u32x4 a1 = *(const u32x4*)(t1 + (size_t)row * 1024 + ch * 8);
              const u32x4 ga = *(const u32x4*)(mg + (size_t)row * 2048 + ch * 8);
              const u32x4 gb = *(const u32x4*)(mg + (size_t)row * 2048 + 1024 + ch * 8);
              u32x4 o;
#pragma unroll
              for (int q4 = 0; q4 < 4; ++q4)
                o[q4] = pk2(bflo(ga[q4]) * bflo(a1[q4]) + bflo(gb[q4]) * bflo(a2[q4]),
                            bfhi(ga[q4]) * bfhi(a1[q4]) + bfhi(gb[q4]) * bfhi(a2[q4]));
              *(u32x4*)(tb + (size_t)row * 1024 + ch * 8) = o;
            }
          }
        }
      }
      xcd_barrier(xb, wv, p.ws);

      {
        char* ws = ptr_opaque(p.ws);
        for (int j = 0, mt, nt; xcd_tile256(j, 4, mt, nt); ++j) {
          f32x16 acc[2][4];
#pragma unroll
          for (int a_ = 0; a_ < 2; ++a_)
#pragma unroll
            for (int b_ = 0; b_ < 4; ++b_) zero16(acc[a_][b_]);
          gemm_core256((const bf16_t*)(ws + OFF_WOUT) + (size_t)layer * 1024 * 1024 + (size_t)nt * 256 * 1024,
                       (const bf16_t*)(ws + OFF_TB) + (size_t)mt * 256 * 1024, 1024, acc, lds, wv);
          const int t2 = tid_opaque(wv), l2 = t2 & 63, w2 = t2 >> 6, r = l2 & 31, h = l2 >> 5, wn = w2 & 3, wm = w2 >> 2;
          char* stage = lds + w2 * 18432;
          stage_acc_bf16(acc, stage, r, h);
          const float* modl = (const float*)(ptr_opaque(p.ws) + OFF_MOD) + (size_t)layer * 10 * 3072;
          const int m0 = mt * 256 + wm * 128;
          const int n0 = nt * 256 + wn * 64;
          const float* gt = modl + (seq0 + (m0 >> lgS)) * 3072 + 2048 + n0;
          const int rr = l2 >> 3, ch = l2 & 7;
          const float4 g0 = *(const float4*)(gt + ch * 8), g1 = *(const float4*)(gt + ch * 8 + 4);
#pragma unroll 4
          for (int i = 0; i < 16; ++i) {
            const int row = rr + 8 * i;
            const u32x4 y = *(const u32x4*)(stage + row * 144 + ch * 16);
            const float* xp = xin + (size_t)(m0 + row) * 1024 + n0 + ch * 8;
            const f32x4v xa = __builtin_nontemporal_load((const f32x4v*)xp), xb4 = __builtin_nontemporal_load((const f32x4v*)(xp + 4));
            const float4 x0 = make_float4(xa[0], xa[1], xa[2], xa[3]), x1 = make_float4(xb4[0], xb4[1], xb4[2], xb4[3]);
            float4 o0, o1;
            o0.x = x0.x + g0.x * bflo(y[0]); o0.y = x0.y + g0.y * bfhi(y[0]);
            o0.z = x0.z + g0.z * bflo(y[1]); o0.w = x0.w + g0.w * bfhi(y[1]);
            o1.x = x1.x + g1.x * bflo(y[2]); o1.y = x1.y + g1.y * bfhi(y[2]);
            o1.z = x1.z + g1.z * bflo(y[3]); o1.w = x1.w + g1.w * bfhi(y[3]);
            float* op = xout + (size_t)(m0 + row) * 1024 + n0 + ch * 8;
            __builtin_nontemporal_store((f32x4v){o0.x, o0.y, o0.z, o0.w}, (f32x4v*)op);
            __builtin_nontemporal_store((f32x4v){o1.x, o1.y, o1.z, o1.w}, (f32x4v*)(op + 4));
          }
        }
      }
      {
        const int nl = rd < 3 ? layer : layer + 1, nr = rd < 3 ? rd + 1 : 0;
        if (nl < 2) h_phase(p, nl, nr, wv);
      }
      xcd_barrier(xb, wv, p.ws);
    }
  }

  const int t = tid_opaque(wv), lane = t & 63, w = t >> 6;
  float4 gf[4];
#pragma unroll
  for (int j = 0; j < 4; ++j) gf[j] = *(const float4*)(p.g_final + (lane + 64 * j) * 4);
  for (int row0 = (blockIdx.x * 8 + w) * 4; row0 < 4 * TR; row0 += gridDim.x * 32) {
    float4 v[4][4];
    float ss[4] = {0.f, 0.f, 0.f, 0.f};
#pragma unroll
    for (int u = 0; u < 4; ++u) {
      const float4* xr = (const float4*)(p.out + (size_t)(row0 + u) * 1024);
#pragma unroll
      for (int j = 0; j < 4; ++j) {
        { const f32x4v q_ = __builtin_nontemporal_load((const f32x4v*)(xr + lane + 64 * j)); v[u][j] = make_float4(q_[0], q_[1], q_[2], q_[3]); }
        ss[u] += v[u][j].x * v[u][j].x + v[u][j].y * v[u][j].y + v[u][j].z * v[u][j].z + v[u][j].w * v[u][j].w;
      }
    }
#pragma unroll
    for (int u = 0; u < 4; ++u) {
      const float rs = rsqrtf(wave_sum(ss[u], lane) * (1.f / 1024.f) + EPSN);
      float4* xr = (float4*)(p.out + (size_t)(row0 + u) * 1024);
#pragma unroll
      for (int j = 0; j < 4; ++j) {
        float4 o;
        o.x = v[u][j].x * rs * gf[j].x; o.y = v[u][j].y * rs * gf[j].y; o.z = v[u][j].z * rs * gf[j].z; o.w = v[u][j].w * rs * gf[j].w;
        __builtin_nontemporal_store((f32x4v){o.x, o.y, o.z, o.w}, (f32x4v*)(xr + lane + 64 * j));
      }
    }
  }
}

extern "C" void kernel_launch(void* const* d_in, const int* in_sizes, int n_in, void* d_out, int out_size, void* d_ws,
                              size_t ws_size, hipStream_t stream) {
  static int grid_blocks = 0;
  if (!grid_blocks) {
    hipFuncSetAttribute((const void*)mega_kernel, hipFuncAttributeMaxDynamicSharedMemorySize, LDS_BYTES);
    int dev = 0, cus = 0, per_cu = 0;
    hipGetDevice(&dev);
    hipDeviceGetAttribute(&cus, hipDeviceAttributeMultiprocessorCount, dev);
    hipOccupancyMaxActiveBlocksPerMultiprocessor(&per_cu, mega_kernel, NTHR, LDS_BYTES);
    if (per_cu > 1) per_cu = 1;
    grid_blocks = cus * per_cu;
  }
  if (ws_size < WS_END) fprintf(stderr, "workspace too small: %zu < %zu\n", ws_size, (size_t)WS_END);
  Params p{};
  p.x_prompt = (const float*)d_in[0];
  p.x_sample = (const float*)d_in[1];
  p.c_prompt = (const float*)d_in[2];
  p.c_sample = (const float*)d_in[3];
  p.w_ada = (const float*)d_in[4];
  p.b_ada = (const float*)d_in[5];
  p.g_norm = (const float*)d_in[6];
  p.w_in = (const float*)d_in[7];
  p.b_gate = (const float*)d_in[8];
  p.g_cq = (const float*)d_in[9];
  p.w_uq = (const float*)d_in[10];
  p.g_ckv = (const float*)d_in[11];
  p.w_ukv = (const float*)d_in[12];
  p.w_pa = (const float*)d_in[13];
  p.w_pb = (const float*)d_in[14];
  p.w_out = (const float*)d_in[15];
  p.g_final = (const float*)d_in[16];
  p.out = (float*)d_out;
  p.ws = (char*)d_ws;
  hipMemsetAsync((char*)d_ws + OFF_BAR, 0, 16384, stream);
  void* args[] = {&p};
  hipError_t e = hipLaunchCooperativeKernel((const void*)mega_kernel, dim3(grid_blocks), dim3(NTHR), args, LDS_BYTES, stream);
  if (e != hipSuccess) fprintf(stderr, "cooperative launch failed: %s (grid %d)\n", hipGetErrorString(e), grid_blocks);
}
```
